# Optimizing an MI355X kernel written in HIP

```python
import jax, jax.numpy as jnp
from jax import lax
import numpy as np

D_MODEL = 2048
BATCH = 4
SEQ = 4096
DEPTH = 1

MIX_WIDTH = D_MODEL
ATTN_WIDTH = MIX_WIDTH // 2
N_ATTN_HEADS = 8
HEAD_DIM = ATTN_WIDTH // N_ATTN_HEADS
ROT_DIM = HEAD_DIM // 4
ROPE_THETA = 500000.0
MOBA_BLOCK = 256
MOBA_TOPK = 3
Q_CHUNK = 32
REC_WIDTH = MIX_WIDTH - ATTN_WIDTH
N_REC_BLOCKS = 16
REC_BLOCK_DIM = REC_WIDTH // N_REC_BLOCKS
CONV_WIDTH = 4
RGLRU_C = 8.0
IN_COLS = 3 * ATTN_WIDTH + 2 * REC_WIDTH
D_FF = ((8 * D_MODEL // 3 + 127) // 128) * 128
FFN_HALF = 0.5
EPS = 1e-6

kernel_name = "macaron_moba_rglru_hybrid_layer"


def rms_norm(x, g):
    x32 = x.astype(jnp.float32)
    y = x32 * lax.rsqrt(jnp.mean(x32 * x32, axis=-1, keepdims=True) + EPS)
    return (y * g.astype(jnp.float32)).astype(x.dtype)


def swiglu(h, w_gate_up, w_down):
    gu = h @ w_gate_up
    g, u = jnp.split(gu, 2, axis=-1)
    return (jax.nn.silu(g) * u) @ w_down


def partial_rope(x, pos):
    inv_freq = ROPE_THETA ** (-jnp.arange(0, ROT_DIM, 2, dtype=jnp.float32) / ROT_DIM)
    ang = pos.astype(jnp.float32)[:, None] * inv_freq[None, :]
    cos, sin = jnp.cos(ang), jnp.sin(ang)
    xr = x[..., :ROT_DIM].astype(jnp.float32)
    x1, x2 = jnp.split(xr, 2, axis=-1)
    rot = jnp.concatenate([x1 * cos - x2 * sin, x2 * cos + x1 * sin], axis=-1)
    return jnp.concatenate([rot.astype(x.dtype), x[..., ROT_DIM:]], axis=-1)


def moba_attention(q, k, v):
    B, H, S, hd = q.shape
    nb = -(-S // MOBA_BLOCK)
    pad = nb * MOBA_BLOCK - S
    kp = jnp.pad(k, ((0, 0), (0, 0), (0, pad), (0, 0)))
    vp = jnp.pad(v, ((0, 0), (0, 0), (0, pad), (0, 0)))
    kb = kp.reshape(B, H, nb, MOBA_BLOCK, hd)
    vb = vp.reshape(B, H, nb, MOBA_BLOCK, hd)
    kmean = jnp.mean(kb.astype(jnp.float32), axis=3)
    k_eff = min(MOBA_TOPK, nb)
    nc = S // Q_CHUNK
    qc = q.reshape(B, H, nc, Q_CHUNK, hd).transpose(2, 0, 1, 3, 4)
    scale = HEAD_DIM ** -0.5
    bi = jnp.arange(B)[:, None, None, None]
    hi = jnp.arange(H)[None, :, None, None]
    blk_ids = jnp.arange(nb)

    def one_chunk(args):
        q_c, c = args
        own = (c * Q_CHUNK) // MOBA_BLOCK
        q_pos = c * Q_CHUNK + jnp.arange(Q_CHUNK)
        q32 = q_c.astype(jnp.float32)
        gate = jnp.einsum('bhqd,bhnd->bhqn', q32, kmean)
        gate = jnp.where(blk_ids < own, gate, -jnp.inf)
        _, sel = lax.top_k(gate, k_eff)
        sel_valid = jnp.arange(k_eff) < own
        k_sel = kb[bi, hi, sel]
        v_sel = vb[bi, hi, sel]
        s_sel = jnp.einsum('bhqd,bhqnkd->bhqnk', q_c, k_sel).astype(jnp.float32) * scale
        s_sel = jnp.where(sel_valid[:, None], s_sel, -jnp.inf)
        s_sel = s_sel.reshape(B, H, Q_CHUNK, k_eff * MOBA_BLOCK)
        k_own = lax.dynamic_index_in_dim(kb, own, axis=2, keepdims=False)
        v_own = lax.dynamic_index_in_dim(vb, own, axis=2, keepdims=False)
        s_own = jnp.einsum('bhqd,bhkd->bhqk', q_c, k_own).astype(jnp.float32) * scale
        key_pos = own * MOBA_BLOCK + jnp.arange(MOBA_BLOCK)
        s_own = jnp.where(key_pos[None, :] <= q_pos[:, None], s_own, -jnp.inf)
        p = jax.nn.softmax(jnp.concatenate([s_sel, s_own], axis=-1), axis=-1)
        p_sel = p[..., :k_eff * MOBA_BLOCK].reshape(B, H, Q_CHUNK, k_eff, MOBA_BLOCK).astype(v.dtype)
        p_own = p[..., k_eff * MOBA_BLOCK:].astype(v.dtype)
        return (jnp.einsum('bhqnk,bhqnkd->bhqd', p_sel, v_sel)
                + jnp.einsum('bhqk,bhkd->bhqd', p_own, v_own))

    out = lax.map(one_chunk, (qc, jnp.arange(nc)))
    return out.transpose(1, 2, 0, 3, 4).reshape(B, H, S, hd)


def causal_depthwise_conv(x, w, b):
    y = lax.conv_general_dilated(
        x, w[:, None, :].astype(x.dtype), window_strides=(1,),
        padding=[(CONV_WIDTH - 1, 0)], dimension_numbers=('NWC', 'WIO', 'NWC'),
        feature_group_count=x.shape[-1])
    return y + b


def rg_lru(x, w_a, b_a, w_x, b_x, lam):
    B, S, R = x.shape
    xb = x.reshape(B, S, N_REC_BLOCKS, REC_BLOCK_DIM)
    r = jax.nn.sigmoid(jnp.einsum('bsni,nij->bsnj', xb, w_a).reshape(B, S, R) + b_a)
    i = jax.nn.sigmoid(jnp.einsum('bsni,nij->bsnj', xb, w_x).reshape(B, S, R) + b_x)
    log_a = (-RGLRU_C * r.astype(jnp.float32)) * jax.nn.softplus(-lam.astype(jnp.float32))
    a = jnp.exp(log_a)
    mult = jnp.sqrt(-jnp.expm1(2.0 * log_a))
    u = mult * (i * x).astype(jnp.float32)

    def combine(c1, c2):
        a1, b1 = c1
        a2, b2 = c2
        return a1 * a2, a2 * b1 + b2

    _, h = lax.associative_scan(combine, (a, u), axis=1)
    return h.astype(x.dtype)


def setup_inputs(seed: int = 0) -> dict:
    key = jax.random.key(seed)
    ks = jax.random.split(key, 32)
    f32 = jnp.float32
    L = DEPTH

    def nrm(k, shape, scale):
        return jax.random.normal(k, shape, f32) * scale

    def gain(k, n):
        return 1.0 + 0.05 * jax.random.normal(k, (L, n), f32)

    a0 = jax.random.uniform(ks[13], (L, REC_WIDTH), f32, 0.9, 0.999)
    return {
        "x": nrm(ks[0], (BATCH, SEQ, D_MODEL), 1.0),
        "ffn1_pre_g": gain(ks[1], D_MODEL),
        "ffn1_w_gate_up": nrm(ks[2], (L, D_MODEL, 2 * D_FF), D_MODEL ** -0.5),
        "ffn1_w_down": nrm(ks[3], (L, D_FF, D_MODEL), D_FF ** -0.5),
        "ffn1_post_g": gain(ks[4], D_MODEL),
        "mix_pre_g": gain(ks[5], D_MODEL),
        "w_in": nrm(ks[6], (L, D_MODEL, IN_COLS), D_MODEL ** -0.5),
        "conv_w": nrm(ks[7], (L, CONV_WIDTH, REC_WIDTH), CONV_WIDTH ** -0.5),
        "conv_b": nrm(ks[8], (L, REC_WIDTH), 0.01),
        "rg_w_a": nrm(ks[9], (L, N_REC_BLOCKS, REC_BLOCK_DIM, REC_BLOCK_DIM), REC_BLOCK_DIM ** -0.5),
        "rg_b_a": nrm(ks[10], (L, REC_WIDTH), 0.01),
        "rg_w_x": nrm(ks[11], (L, N_REC_BLOCKS, REC_BLOCK_DIM, REC_BLOCK_DIM), REC_BLOCK_DIM ** -0.5),
        "rg_b_x": nrm(ks[12], (L, REC_WIDTH), 0.01),
        "rg_lambda": jnp.log(a0) - jnp.log1p(-a0),
        "attn_out_g": gain(ks[14], ATTN_WIDTH),
        "rec_out_g": gain(ks[15], REC_WIDTH),
        "w_out": nrm(ks[16], (L, MIX_WIDTH, D_MODEL), MIX_WIDTH ** -0.5),
        "mix_post_g": gain(ks[17], D_MODEL),
        "ffn2_pre_g": gain(ks[18], D_MODEL),
        "ffn2_w_gate_up": nrm(ks[19], (L, D_MODEL, 2 * D_FF), D_MODEL ** -0.5),
        "ffn2_w_down": nrm(ks[20], (L, D_FF, D_MODEL), D_FF ** -0.5),
        "ffn2_post_g": gain(ks[21], D_MODEL),
    }


def reference(x, ffn1_pre_g, ffn1_w_gate_up, ffn1_w_down, ffn1_post_g,
              mix_pre_g, w_in, conv_w, conv_b, rg_w_a, rg_b_a, rg_w_x, rg_b_x,
              rg_lambda, attn_out_g, rec_out_g, w_out, mix_post_g,
              ffn2_pre_g, ffn2_w_gate_up, ffn2_w_down, ffn2_post_g):
    B, S, _ = x.shape
    pos = jnp.arange(S, dtype=jnp.int32)
    splits = [ATTN_WIDTH, 2 * ATTN_WIDTH, 3 * ATTN_WIDTH, 3 * ATTN_WIDTH + REC_WIDTH]

    def heads(t):
        return t.reshape(B, S, N_ATTN_HEADS, HEAD_DIM).transpose(0, 2, 1, 3)

    for l in range(DEPTH):
        f = swiglu(rms_norm(x, ffn1_pre_g[l]), ffn1_w_gate_up[l], ffn1_w_down[l])
        x = x + FFN_HALF * rms_norm(f, ffn1_post_g[l])

        h = rms_norm(x, mix_pre_g[l])
        proj = h @ w_in[l]
        q, k, v, xr, gr = jnp.split(proj, splits, axis=-1)
        q = partial_rope(heads(q), pos)
        k = partial_rope(heads(k), pos)
        attn = moba_attention(q, k, heads(v))
        attn = attn.transpose(0, 2, 1, 3).reshape(B, S, ATTN_WIDTH)
        xc = causal_depthwise_conv(xr, conv_w[l], conv_b[l])
        rec = rg_lru(xc, rg_w_a[l], rg_b_a[l], rg_w_x[l], rg_b_x[l], rg_lambda[l])
        rec = rec * jax.nn.gelu(gr)
        merged = jnp.concatenate([rms_norm(attn, attn_out_g[l]),
                                  rms_norm(rec, rec_out_g[l])], axis=-1)
        y = merged @ w_out[l]
        x = x + rms_norm(y, mix_post_g[l])

        f = swiglu(rms_norm(x, ffn2_pre_g[l]), ffn2_w_gate_up[l], ffn2_w_down[l])
        x = x + FFN_HALF * rms_norm(f, ffn2_post_g[l])
    return x
```

```cpp
#include <hip/hip_runtime.h>
#include <cstdio>
#include <cstdint>
#include <cmath>
namespace pg8 {
#define PG8_LAS __attribute__((address_space(3)))
typedef unsigned short bf16_t;
typedef short bf16x8 __attribute__((ext_vector_type(8)));
typedef float f32x4 __attribute__((ext_vector_type(4)));
typedef unsigned u32x4 __attribute__((ext_vector_type(4)));
constexpr int BM = 256, BK = 64, HALF = 128, HTB = HALF * BK * 2  , STAGE_BYTES = 8 * HTB, NXCD = 8, WGM = 8;

__host__ __device__ __forceinline__ int lds_byte(int r, int c) { const int st = (r >> 4) * 2 + (c >> 5), rr = r & 15, cc = c & 31, ob = rr * 64 + cc * 2; return st * 1024 + (ob ^ (((ob >> 9) & 1) << 5)); }
__host__ __device__ __forceinline__ void stage_rc(int b, int& R, int& C) { const int st = b / 1024, sb = b % 1024, swz = sb ^ (((sb >> 9) & 1) << 5); R = (st >> 1) * 16 + swz / 64; C = (st & 1) * 32 + (swz % 64) / 2; }
__host__ __device__ __forceinline__ int perm32(int rho) { const int n = rho >> 4, i = rho & 15; return 8 * (i >> 2) + 4 * n + (i & 3); }

struct Unit { int pm, pn; };
struct Gemm { const bf16_t* A; const bf16_t* Bt; int M, N, K; };

struct StaticOrder {
    int nM, nN, nwg, G, c;
    __host__ __device__ void init(int M, int N, int G_, int c_) { nM = M / BM; nN = N / BM; nwg = nM * nN; G = G_; c = c_; }
    __host__ __device__ bool next(int i, Unit& u) const {
        const long L = (long)i * G + c; if (L >= nwg) return false;
        int wgid = (int)L; { const int q = nwg / NXCD, r = nwg % NXCD, xcd = wgid % NXCD, off = wgid / NXCD; wgid = (xcd < r ? xcd * (q + 1) : r * (q + 1) + (xcd - r) * q) + off; }
        const int nig = WGM * nN, gid = wgid / nig, fm = gid * WGM, gsz = (nM - fm) < WGM ? (nM - fm) : WGM;
        u.pm = fm + ((wgid % nig) % gsz); u.pn = (wgid % nig) / gsz; return true;
    }
    __device__ __forceinline__ void a_ready(const Unit&) const {}
    __device__ __forceinline__ void done(const Unit&) const {}
};

__device__ __forceinline__ unsigned cvt_pk_bf16(float lo, float hi) { unsigned r; asm volatile("v_cvt_pk_bf16_f32 %0, %1, %2" : "=v"(r) : "v"(lo), "v"(hi)); return r; }
typedef float f32x2 __attribute__((ext_vector_type(2)));
typedef f32x4 Acc[2][2][4][2];

struct NoMid { static constexpr bool ENABLED = false; __device__ __forceinline__ void operator()(Acc&, int, int, int) const {} };

struct EpiBf16 {
    static constexpr bool PERM = true, AFTER_DRAIN = false;
    bf16_t* O; int ldc;
    __device__ __forceinline__ void operator()(Acc& acc, const Unit& u, int ui, int wr, int wc, int fr, int fq) const {
        const int row0 = u.pm * BM + wr * 64 + fr, col0 = u.pn * BM + wc * 32 + 8 * fq;
#pragma unroll
        for (int ai = 0; ai < 2; ++ai)
#pragma unroll
            for (int m = 0; m < 4; ++m) { bf16_t* rowp = O + (size_t)(row0 + ai * HALF + m * 16) * ldc + col0;
#pragma unroll
                for (int bj = 0; bj < 2; ++bj) { const f32x4 v0 = acc[ai][bj][m][0], v1 = acc[ai][bj][m][1];
                    u32x4 w; w.x = cvt_pk_bf16(v0[0], v0[1]); w.y = cvt_pk_bf16(v0[2], v0[3]); w.z = cvt_pk_bf16(v1[0], v1[1]); w.w = cvt_pk_bf16(v1[2], v1[3]);
                    *(u32x4*)(rowp + bj * HALF) = w; } }
    }
};
__device__ __forceinline__ float silu_mul(float g, float u) { return g * u * __builtin_amdgcn_rcpf(1.0f + __builtin_amdgcn_exp2f(-1.4426950408889634f * g)); }
struct EpiSwiGLU {
    static constexpr bool PERM = true, AFTER_DRAIN = false;
    bf16_t* O; int ldc;
    __device__ __forceinline__ void operator()(Acc& acc, const Unit& u, int ui, int wr, int wc, int fr, int fq) const {
        const int row0 = u.pm * BM + wr * 64 + fr, col0 = u.pn * HALF + wc * 32 + 8 * fq;
#pragma unroll
        for (int ai = 0; ai < 2; ++ai)
#pragma unroll
            for (int m = 0; m < 4; ++m) { bf16_t* rowp = O + (size_t)(row0 + ai * HALF + m * 16) * ldc + col0;
                const f32x4 g0 = acc[ai][0][m][0], g1 = acc[ai][0][m][1], u0 = acc[ai][1][m][0], u1 = acc[ai][1][m][1];
                u32x4 w; w.x = cvt_pk_bf16(silu_mul(g0[0], u0[0]), silu_mul(g0[1], u0[1])); w.y = cvt_pk_bf16(silu_mul(g0[2], u0[2]), silu_mul(g0[3], u0[3]));
                w.z = cvt_pk_bf16(silu_mul(g1[0], u1[0]), silu_mul(g1[1], u1[1])); w.w = cvt_pk_bf16(silu_mul(g1[2], u1[2]), silu_mul(g1[3], u1[3]));
                *(u32x4*)rowp = w; }
    }
};
struct MidRowScale {
    static constexpr bool ENABLED = true;
    const PG8_LAS float* scl;
    __device__ __forceinline__ void operator()(Acc& acc, int ui, int wr, int fr) const {
#pragma unroll
        for (int ai = 0; ai < 2; ++ai)
#pragma unroll
            for (int m = 0; m < 4; ++m) { const float s = scl[(ui * 256 + ai * HALF + wr * 64 + m * 16 + fr) * 2];
#pragma unroll
                for (int bj = 0; bj < 2; ++bj)
#pragma unroll
                    for (int n = 0; n < 2; ++n) acc[ai][bj][m][n] = acc[ai][bj][m][n] * s; }
    }
};
struct EpiRowScaleBf16 {
    static constexpr bool PERM = true, AFTER_DRAIN = false;
    bf16_t* O; int ldc; const PG8_LAS float* scl;
    __device__ __forceinline__ void operator()(Acc& acc, const Unit& u, int ui, int wr, int wc, int fr, int fq) const {
        const int row0 = u.pm * BM + wr * 64 + fr, col0 = u.pn * BM + wc * 32 + 8 * fq;
#pragma unroll
        for (int ai = 0; ai < 2; ++ai)
#pragma unroll
            for (int m = 0; m < 4; ++m) { bf16_t* rowp = O + (size_t)(row0 + ai * HALF + m * 16) * ldc + col0;
                const float s = scl[(ui * 256 + ai * HALF + wr * 64 + m * 16 + fr) * 2 + 1];
#pragma unroll
                for (int bj = 0; bj < 2; ++bj) { const f32x4 v0 = acc[ai][bj][m][0] * s, v1 = acc[ai][bj][m][1] * s;
                    u32x4 w; w.x = cvt_pk_bf16(v0[0], v0[1]); w.y = cvt_pk_bf16(v0[2], v0[3]); w.z = cvt_pk_bf16(v1[0], v1[1]); w.w = cvt_pk_bf16(v1[2], v1[3]);
                    *(u32x4*)(rowp + bj * HALF) = w; } }
    }
};
struct EpiProj {
    static constexpr bool PERM = true, AFTER_DRAIN = false;
    unsigned char* base5; const float* rope; float* kmean;
    __device__ __forceinline__ void operator()(Acc& acc, const Unit& u, int ui, int wr, int wc, int fr, int fq) const {
        const int region = u.pn >> 2, sub = u.pn & 3;
        if (region >= 3) {
            bf16_t* O = (bf16_t*)(base5 + (size_t)region * (32u << 20));
            const int row0 = u.pm * BM + wr * 64 + fr, col0 = sub * BM + wc * 32 + 8 * fq;
#pragma unroll
            for (int ai = 0; ai < 2; ++ai)
#pragma unroll
                for (int m = 0; m < 4; ++m) { bf16_t* rowp = O + (size_t)(row0 + ai * HALF + m * 16) * 1024 + col0;
#pragma unroll
                    for (int bj = 0; bj < 2; ++bj) { const f32x4 v0 = acc[ai][bj][m][0], v1 = acc[ai][bj][m][1];
                        u32x4 w; w.x = cvt_pk_bf16(v0[0], v0[1]); w.y = cvt_pk_bf16(v0[2], v0[3]); w.z = cvt_pk_bf16(v1[0], v1[1]); w.w = cvt_pk_bf16(v1[2], v1[3]);
                        *(u32x4*)(rowp + bj * HALF) = w; } }
            return;
        }
        const int b = u.pm >> 4, blk = u.pm & 15, s0 = blk * 256 + wr * 64 + fr;
        bf16_t* dst = (bf16_t*)(base5 + (size_t)region * (32u << 20));
        bf16_t* base = dst + ((size_t)(b * 8 + sub * 2) * 4096 + s0) * 128 + wc * 32 + 8 * fq;
        f32x4 ks[2][2];
#pragma unroll
        for (int bj = 0; bj < 2; ++bj)
#pragma unroll
            for (int n = 0; n < 2; ++n) ks[bj][n] = (f32x4){0.f, 0.f, 0.f, 0.f};
        if (region < 2 && wc == 0) {
            const float sgn = fq < 2 ? -1.0f : 1.0f;
            const float* rp = rope + ((size_t)s0 * 16 + 8 * (fq & 1)) * 2;
#pragma unroll
            for (int ai = 0; ai < 2; ++ai)
#pragma unroll
                for (int m = 0; m < 4; ++m) { const f32x4* cs = (const f32x4*)(rp + (size_t)(ai * HALF + m * 16) * 32);
#pragma unroll
                    for (int bj = 0; bj < 2; ++bj) { f32x4 o[2];
#pragma unroll
                        for (int n = 0; n < 2; ++n) { const f32x4 ca = cs[2 * n], cb = cs[2 * n + 1]; const f32x4 v = acc[ai][bj][m][n];
                            const f32x4 p = (f32x4){__shfl_xor(v[0], 32), __shfl_xor(v[1], 32), __shfl_xor(v[2], 32), __shfl_xor(v[3], 32)};
                            o[n] = (f32x4){fmaf(sgn * p[0], ca[1], v[0] * ca[0]), fmaf(sgn * p[1], ca[3], v[1] * ca[2]), fmaf(sgn * p[2], cb[1], v[2] * cb[0]), fmaf(sgn * p[3], cb[3], v[3] * cb[2])}; }
                        u32x4 w; w.x = cvt_pk_bf16(o[0][0], o[0][1]); w.y = cvt_pk_bf16(o[0][2], o[0][3]); w.z = cvt_pk_bf16(o[1][0], o[1][1]); w.w = cvt_pk_bf16(o[1][2], o[1][3]);
                        *(u32x4*)(base + (size_t)bj * 4096 * 128 + (size_t)(ai * HALF + m * 16) * 128) = w;
                        ks[bj][0] += o[0]; ks[bj][1] += o[1]; } }
        } else {
#pragma unroll
            for (int ai = 0; ai < 2; ++ai)
#pragma unroll
                for (int m = 0; m < 4; ++m)
#pragma unroll
                    for (int bj = 0; bj < 2; ++bj) { const f32x4 v0 = acc[ai][bj][m][0], v1 = acc[ai][bj][m][1];
                        u32x4 w; w.x = cvt_pk_bf16(v0[0], v0[1]); w.y = cvt_pk_bf16(v0[2], v0[3]); w.z = cvt_pk_bf16(v1[0], v1[1]); w.w = cvt_pk_bf16(v1[2], v1[3]);
                        *(u32x4*)(base + (size_t)bj * 4096 * 128 + (size_t)(ai * HALF + m * 16) * 128) = w;
                        ks[bj][0] += v0; ks[bj][1] += v1; }
        }
        if (region == 1) {
#pragma unroll
            for (int bj = 0; bj < 2; ++bj) { float* kd = kmean + ((size_t)(b * 8 + sub * 2 + bj) * 16 + blk) * 128 + wc * 32 + 8 * fq;
#pragma unroll
                for (int n = 0; n < 2; ++n)
#pragma unroll
                    for (int j = 0; j < 4; ++j) { float t = ks[bj][n][j]; t += __shfl_xor(t, 1); t += __shfl_xor(t, 2); t += __shfl_xor(t, 4); t += __shfl_xor(t, 8);
                        if (fr == 0) unsafeAtomicAdd(kd + 4 * n + j, t); } }
        }
    }
};

template <class Epi, class Sched, class Mid, bool ALIGN_EPI = false, bool SP2 = false>
__device__ __forceinline__ void gemm_phase(PG8_LAS unsigned char* lds, const Gemm g, const Sched& S, const Epi& E, const Mid& MH) {
    const int tid = threadIdx.x, wid = __builtin_amdgcn_readfirstlane(tid >> 6), lane = tid & 63, wr = wid >> 2, wc = wid & 3, fr = lane & 15, fq = lane >> 4;
    const int K = g.K, nt = K / BK;
    unsigned voffA[2], voffB[2];
#pragma unroll
    for (int i = 0; i < 2; ++i) { int R, C; stage_rc(tid * 16 + i * 8192, R, C); const int Rb = Epi::PERM ? ((R & ~31) + perm32(R & 31)) : R;
        voffA[i] = (unsigned)(R * K + C) * 2u; voffB[i] = (unsigned)(Rb * K + C) * 2u; }
    const size_t kstep = (size_t)(BK * 2);
    const size_t hstep = (size_t)HALF * K * 2;
    const size_t tstep = 2 * hstep;
    const unsigned ldsw = (unsigned)wid * 1024u;
    const int aoff = lds_byte(wr * 64 + fr, fq * 8), boff = lds_byte(wc * 32 + fr, fq * 8);
#define PG8_SA(b, h) (((b) * 2 + (h)) * HTB)
#define PG8_SB(b, h) ((4 + (b) * 2 + (h)) * HTB)
#define PG8_STAGE(bufoff, gbase, voff) do { _Pragma("unroll") for (int _i = 0; _i < 2; ++_i) \
        __builtin_amdgcn_global_load_lds((const unsigned*)((const char*)(gbase) + (voff)[_i]), (PG8_LAS unsigned*)(lds + (bufoff) + ldsw + _i * 8192), 16, 0, 0); } while (0)
#define PG8_LDA(dst, b, h) do { _Pragma("unroll") for (int m = 0; m < 4; ++m) _Pragma("unroll") for (int k = 0; k < 2; ++k) dst[m][k] = *(const PG8_LAS bf16x8*)(lds + PG8_SA(b, h) + aoff + m * 2048 + k * 1024); } while (0)
#define PG8_LDB(dst, b, h) do { _Pragma("unroll") for (int n = 0; n < 2; ++n) _Pragma("unroll") for (int k = 0; k < 2; ++k) dst[n][k] = *(const PG8_LAS bf16x8*)(lds + PG8_SB(b, h) + boff + n * 2048 + k * 1024); } while (0)
#define PG8_MMA(ai, bj, At, Bt) do { __builtin_amdgcn_s_setprio(1); _Pragma("unroll") for (int m = 0; m < 4; ++m) _Pragma("unroll") for (int n = 0; n < 2; ++n) _Pragma("unroll") for (int k = 0; k < 2; ++k) \
        acc[ai][bj][m][n] = __builtin_amdgcn_mfma_f32_16x16x32_bf16(Bt[n][k], At[m][k], acc[ai][bj][m][n], 0, 0, 0); __builtin_amdgcn_s_setprio(0); } while (0)
#define PG8_WAIT_V(n) asm volatile("s_waitcnt vmcnt(" #n ")" ::: "memory")
#define PG8_WAIT_L(n) asm volatile("s_waitcnt lgkmcnt(" #n ")" ::: "memory")
#define PG8_BAR __builtin_amdgcn_s_barrier()
#define PG8_SCHED __builtin_amdgcn_sched_barrier(0)
    Unit cur, nxt; int ui = 0;
    if (!S.next(0, cur)) return;
    Acc acc;
#pragma unroll
    for (int a = 0; a < 2; ++a)
#pragma unroll
        for (int b = 0; b < 2; ++b)
#pragma unroll
            for (int m = 0; m < 4; ++m)
#pragma unroll
                for (int n = 0; n < 2; ++n) acc[a][b][m][n] = (f32x4){0.f, 0.f, 0.f, 0.f};
    bf16x8 At[4][2], B0[2][2], B1[2][2];
    const char* cA = (const char*)g.A + (size_t)cur.pm * tstep; const char* cB = (const char*)g.Bt + (size_t)cur.pn * tstep;
    S.a_ready(cur);
    if constexpr (SP2) {
        PG8_STAGE(PG8_SB(0, 0), cB, voffB); PG8_STAGE(PG8_SB(0, 1), cB + hstep, voffB); PG8_STAGE(PG8_SA(0, 0), cA, voffA); PG8_STAGE(PG8_SA(0, 1), cA + hstep, voffA);
        if (wr == 1) PG8_BAR;
        PG8_WAIT_V(2); PG8_BAR;
        PG8_STAGE(PG8_SB(1, 0), cB + kstep, voffB); PG8_STAGE(PG8_SA(1, 0), cA + kstep, voffA); PG8_STAGE(PG8_SB(1, 1), cB + hstep + kstep, voffB);
        PG8_WAIT_V(6); PG8_BAR;
    } else {
        PG8_STAGE(PG8_SB(0, 0), cB, voffB); PG8_STAGE(PG8_SA(0, 0), cA, voffA); PG8_STAGE(PG8_SB(0, 1), cB + hstep, voffB); PG8_STAGE(PG8_SA(0, 1), cA + hstep, voffA);
        if (wr == 1) PG8_BAR;
        PG8_WAIT_V(4); PG8_BAR;
        PG8_STAGE(PG8_SB(1, 0), cB + kstep, voffB); PG8_STAGE(PG8_SA(1, 0), cA + kstep, voffA); PG8_STAGE(PG8_SB(1, 1), cB + hstep + kstep, voffB);
        PG8_WAIT_V(6); PG8_BAR;
    }
    for (;;) {
        const bool has_next = S.next(ui + 1, nxt);
        const char* nA = has_next ? (const char*)g.A + (size_t)nxt.pm * tstep : cA; const char* nB = has_next ? (const char*)g.Bt + (size_t)nxt.pn * tstep : cB;
        for (int t = 0; t < nt; t += 2) {
            const bool last = (t == nt - 2);
            const char* a1 = cA + (size_t)(t + 1) * kstep;
            const char* a2 = last ? nA : cA + (size_t)(t + 2) * kstep; const char* b2 = last ? nB : cB + (size_t)(t + 2) * kstep;
            const char* a3 = a2 + kstep; const char* b3 = b2 + kstep;
            if (last && has_next) S.a_ready(nxt);
            if constexpr (Mid::ENABLED) { if (t == (nt >> 1)) MH(acc, ui, wr, fr); }
            if constexpr (SP2) {
            PG8_LDB(B0, 0, 0); PG8_LDB(B1, 0, 1); PG8_SCHED; PG8_LDA(At, 0, 0); PG8_STAGE(PG8_SA(1, 1), a1 + hstep, voffA);
            PG8_WAIT_V(8); PG8_WAIT_L(0); PG8_BAR; PG8_MMA(0, 0, At, B0); PG8_MMA(0, 1, At, B1); PG8_BAR; PG8_SCHED;
            PG8_LDA(At, 0, 1); PG8_STAGE(PG8_SB(0, 0), b2, voffB); PG8_STAGE(PG8_SB(0, 1), b2 + hstep, voffB); PG8_STAGE(PG8_SA(0, 0), a2, voffA);
            PG8_WAIT_V(8); PG8_WAIT_L(0); PG8_BAR; PG8_MMA(1, 0, At, B0); PG8_MMA(1, 1, At, B1); PG8_BAR; PG8_SCHED;
            PG8_LDB(B0, 1, 0); PG8_LDB(B1, 1, 1); PG8_SCHED; PG8_LDA(At, 1, 0); PG8_STAGE(PG8_SA(0, 1), a2 + hstep, voffA);
            PG8_WAIT_V(8); PG8_WAIT_L(0); PG8_BAR; PG8_MMA(0, 0, At, B0); PG8_MMA(0, 1, At, B1); PG8_BAR; PG8_SCHED;
            PG8_LDA(At, 1, 1); PG8_STAGE(PG8_SB(1, 0), b3, voffB); PG8_STAGE(PG8_SB(1, 1), b3 + hstep, voffB); PG8_STAGE(PG8_SA(1, 0), a3, voffA);
            PG8_WAIT_V(8); PG8_WAIT_L(0); PG8_BAR; PG8_MMA(1, 0, At, B0); PG8_MMA(1, 1, At, B1); PG8_BAR; PG8_SCHED;
            } else {
            PG8_LDB(B0, 0, 0); PG8_SCHED; PG8_LDA(At, 0, 0); PG8_STAGE(PG8_SA(1, 1), a1 + hstep, voffA);
            PG8_WAIT_L(8); PG8_BAR; PG8_WAIT_L(0); PG8_MMA(0, 0, At, B0); PG8_BAR; PG8_SCHED;
            PG8_LDB(B1, 0, 1); PG8_STAGE(PG8_SB(0, 0), b2, voffB);
            PG8_BAR; PG8_WAIT_L(0); PG8_MMA(0, 1, At, B1); PG8_BAR;
            PG8_LDA(At, 0, 1); PG8_STAGE(PG8_SA(0, 0), a2, voffA);
            PG8_BAR; PG8_WAIT_L(0); PG8_MMA(1, 0, At, B0); PG8_BAR; PG8_SCHED;
            PG8_STAGE(PG8_SB(0, 1), b2 + hstep, voffB);
            PG8_WAIT_V(6); PG8_BAR; PG8_MMA(1, 1, At, B1); PG8_BAR;
            PG8_LDB(B0, 1, 0); PG8_SCHED; PG8_LDA(At, 1, 0); PG8_STAGE(PG8_SA(0, 1), a2 + hstep, voffA);
            PG8_WAIT_L(8); PG8_BAR; PG8_WAIT_L(0); PG8_MMA(0, 0, At, B0); PG8_BAR; PG8_SCHED;
            PG8_LDB(B1, 1, 1); PG8_STAGE(PG8_SB(1, 0), b3, voffB);
            PG8_BAR; PG8_WAIT_L(0); PG8_MMA(0, 1, At, B1); PG8_BAR;
            PG8_LDA(At, 1, 1); PG8_STAGE(PG8_SA(1, 0), a3, voffA);
            PG8_BAR; PG8_WAIT_L(0); PG8_MMA(1, 0, At, B0); PG8_BAR; PG8_SCHED;
            PG8_STAGE(PG8_SB(1, 1), b3 + hstep, voffB);
            PG8_WAIT_V(6); PG8_BAR; PG8_MMA(1, 1, At, B1); PG8_BAR;
            }
        }
        if constexpr (ALIGN_EPI) { if (wr == 0) PG8_BAR; }
        E(acc, cur, ui, wr, wc, fr, fq);
        if (!has_next) break;
#pragma unroll
        for (int a = 0; a < 2; ++a)
#pragma unroll
            for (int b = 0; b < 2; ++b)
#pragma unroll
                for (int m = 0; m < 4; ++m)
#pragma unroll
                    for (int n = 0; n < 2; ++n) acc[a][b][m][n] = (f32x4){0.f, 0.f, 0.f, 0.f};
        cur = nxt; cA = nA; cB = nB; ++ui;
        if constexpr (ALIGN_EPI) { if (wr == 1) PG8_BAR; }
    }
    PG8_WAIT_V(0);
    if constexpr (!ALIGN_EPI) { if (wr == 0) PG8_BAR; }
    PG8_BAR;
#undef PG8_SA
#undef PG8_SB
#undef PG8_STAGE
#undef PG8_LDA
#undef PG8_LDB
#undef PG8_MMA
#undef PG8_WAIT_V
#undef PG8_WAIT_L
#undef PG8_BAR
#undef PG8_SCHED
}
}

namespace moba {
constexpr int D = 128, SKV = 4096, OPITCH = 2048;
constexpr float SCALE = 0.08838834764831845f;
constexpr float THR = 8.f;
constexpr int NW = 8, QBLK = 32, KVBLK = 64, QB = NW * QBLK;
constexpr int SHM_V = KVBLK * D * 2, SHM_K = KVBLK * D * 2;
constexpr int LDS_WS = 2 * SHM_V + 2 * SHM_K, LDS_KM = LDS_WS + NW * 64 * 4, LDS_BYTES = LDS_KM + 16 * 128 * 4;
typedef unsigned short bf16;
typedef short bf16x8 __attribute__((ext_vector_type(8)));
typedef short s16x4 __attribute__((ext_vector_type(4)));
typedef float f32x16 __attribute__((ext_vector_type(16)));
typedef float f32x4 __attribute__((ext_vector_type(4)));
typedef unsigned u32x4 __attribute__((ext_vector_type(4)));

#define KSWZ(row, colB) ((row) * 256 + ((colB) ^ (((row) & 7) << 4)))
#define SBAR() __builtin_amdgcn_sched_barrier(0)
__device__ __forceinline__ int v_st(int k, int c) { const int kk = (k & ~0xC) | ((k & 4) << 1) | ((k & 8) >> 1); return ((kk >> 3) * 4 + (c >> 5)) * 512 + ((kk & 7) * 32 + (c & 31)) * 2; }
__device__ __forceinline__ int v_rd_base(int lane) { return ((lane & 3) << 3) | (((lane >> 2) & 3) << 6) | (((lane >> 4) & 1) << 5) | (((lane >> 5) & 1) << 8); }
constexpr int v_rd_off(int d0, int ks, int half) { return d0 * 512 + ks * 4096 + half * 2048; }
__device__ __forceinline__ int crow(int r, int hi) { return (r & 3) + 8 * (r >> 2) + 4 * hi; }
__device__ __forceinline__ unsigned cvtpk(float lo, float hi) { unsigned r; asm volatile("v_cvt_pk_bf16_f32 %0, %1, %2" : "=v"(r) : "v"(lo), "v"(hi)); return r; }
__device__ __forceinline__ bf16x8 load8(const bf16* p) { return *reinterpret_cast<const bf16x8*>(p); }
__device__ __forceinline__ void mask_tile(f32x16& p0, f32x16& p1, int dq) {
    const float NEG = -__builtin_inff();
#pragma unroll
    for (int r = 0; r < 16; ++r) {
        const int c = (r & 3) + 8 * (r >> 2);
        if (dq - c < 0) p0[r] = NEG;
        if (dq - c - 32 < 0) p1[r] = NEG;
    }
}
__device__ __forceinline__ void mask_all(f32x16& p0, f32x16& p1, bool keep) {
    const float NEG = -__builtin_inff();
#pragma unroll
    for (int r = 0; r < 16; ++r) { p0[r] = keep ? p0[r] : NEG; p1[r] = keep ? p1[r] : NEG; }
}
__device__ __forceinline__ void partialSM(f32x16& p0, f32x16& p1, float& m_reg, float& mn, float& alpha) {
    float pmax = p0[0]; for (int r = 1; r < 16; ++r) pmax = fmaxf(pmax, p0[r]); for (int r = 0; r < 16; ++r) pmax = fmaxf(pmax, p1[r]);
    { auto rr = __builtin_amdgcn_permlane32_swap(__float_as_uint(pmax), __float_as_uint(pmax), false, false);
      pmax = fmaxf(__uint_as_float(rr[0]), __uint_as_float(rr[1])); }
    constexpr float C2 = 1.4426950408889634f * SCALE;
    if (__builtin_expect(__all((pmax - m_reg) * SCALE <= THR), 1)) { mn = m_reg; alpha = 1.f; }
    else { mn = fmaxf(m_reg, pmax); alpha = __builtin_amdgcn_exp2f((m_reg - mn) * C2); m_reg = mn; }
    const float mnL = -mn * C2;
    for (int r = 0; r < 16; ++r) p0[r] = fmaf(p0[r], C2, mnL); for (int r = 0; r < 16; ++r) p1[r] = fmaf(p1[r], C2, mnL);
    for (int r = 0; r < 16; ++r) p0[r] = __builtin_amdgcn_exp2f(p0[r]);
}
__device__ __forceinline__ void finishSM(f32x16& p0, f32x16& p1, float alpha, float& l_reg, bf16x8& pa0, bf16x8& pa1, bf16x8& pa2, bf16x8& pa3) {
    for (int r = 0; r < 16; ++r) p1[r] = __builtin_amdgcn_exp2f(p1[r]);
    float ps = 0; for (int r = 0; r < 16; ++r) ps += p0[r]; for (int r = 0; r < 16; ++r) ps += p1[r];
    { auto rr = __builtin_amdgcn_permlane32_swap(__float_as_uint(ps), __float_as_uint(ps), false, false);
      ps = __uint_as_float(rr[0]) + __uint_as_float(rr[1]); }
    l_reg = l_reg * alpha + ps;
#define PK4(P, B_, OUT) do { unsigned a0 = cvtpk(P[B_+0], P[B_+1]), a1 = cvtpk(P[B_+2], P[B_+3]);                          \
        unsigned b0 = cvtpk(P[B_+4], P[B_+5]), b1 = cvtpk(P[B_+6], P[B_+7]);                                             \
        auto r0 = __builtin_amdgcn_permlane32_swap(a0, b0, false, false); auto r1 = __builtin_amdgcn_permlane32_swap(a1, b1, false, false); \
        u32x4 w = {r0[0], r1[0], r0[1], r1[1]}; OUT = *reinterpret_cast<bf16x8*>(&w); } while (0)
    PK4(p0, 0, pa0); PK4(p0, 8, pa1); PK4(p1, 0, pa2); PK4(p1, 8, pa3);
#undef PK4
}
template <int KB>
__device__ __forceinline__ void qkt(f32x16& p0, f32x16& p1, const char* K_lds, int r32, int hi, const bf16x8* qr) {
    p0 = f32x16{}; p1 = f32x16{};
    const char* kb[4];
#pragma unroll
    for (int dd = 0; dd < 4; ++dd) kb[dd] = K_lds + KB * SHM_K + KSWZ(r32, (dd * 16 + hi * 8) * 2);
#pragma unroll
    for (int d0 = 0; d0 < 8; ++d0) { const char* a = kb[d0 & 3] + (d0 >> 2) * 128;
        bf16x8 b0 = *reinterpret_cast<const bf16x8*>(a);
        bf16x8 b1 = *reinterpret_cast<const bf16x8*>(a + 32 * 256);
        p0 = __builtin_amdgcn_mfma_f32_32x32x16_bf16(b0, qr[d0], p0, 0, 0, 0);
        p1 = __builtin_amdgcn_mfma_f32_32x32x16_bf16(b1, qr[d0], p1, 0, 0, 0); }
}
template <int VB>
__device__ __forceinline__ void pv_tile(f32x16* o, int vb0, bf16x8 pa0, bf16x8 pa1, bf16x8 pa2, bf16x8 pa3) {
#define TRRD(dst, off) asm volatile("ds_read_b64_tr_b16 %0, %1 offset:%2" : "=&v"(dst) : "v"(vb0), "i"(off) : "memory")
#define PV_D0(d0) do { s16x4 l0, l1, l2, l3, h0, h1, h2, h3; constexpr int b_ = VB * SHM_V + v_rd_off(d0, 0, 0);     \
        TRRD(l0, b_); TRRD(h0, b_ + 2048); TRRD(l1, b_ + 4096); TRRD(h1, b_ + 6144); TRRD(l2, b_ + 8192); TRRD(h2, b_ + 10240); TRRD(l3, b_ + 12288); TRRD(h3, b_ + 14336); \
        asm volatile("s_waitcnt lgkmcnt(0)" ::: "memory"); SBAR();                 \
        o[d0] = __builtin_amdgcn_mfma_f32_32x32x16_bf16(pa0, (bf16x8){l0[0], l0[1], l0[2], l0[3], h0[0], h0[1], h0[2], h0[3]}, o[d0], 0, 0, 0);   \
        o[d0] = __builtin_amdgcn_mfma_f32_32x32x16_bf16(pa1, (bf16x8){l1[0], l1[1], l1[2], l1[3], h1[0], h1[1], h1[2], h1[3]}, o[d0], 0, 0, 0);   \
        o[d0] = __builtin_amdgcn_mfma_f32_32x32x16_bf16(pa2, (bf16x8){l2[0], l2[1], l2[2], l2[3], h2[0], h2[1], h2[2], h2[3]}, o[d0], 0, 0, 0);   \
        o[d0] = __builtin_amdgcn_mfma_f32_32x32x16_bf16(pa3, (bf16x8){l3[0], l3[1], l3[2], l3[3], h3[0], h3[1], h3[2], h3[3]}, o[d0], 0, 0, 0); } while (0)
    PV_D0(0); PV_D0(1); PV_D0(2); PV_D0(3);
#undef PV_D0
#undef TRRD
}
struct BlockRef { const bf16* Q; const bf16* K; const bf16* V; bf16* O; float* SS; const float* KM; int P0; };
struct Seam { bf16x8 qr[8]; bf16x8 st_v0, st_v1, st_k0, st_k1; };
#define ROW(p, k0, rr) ((p) + (size_t)((k0) + (rr)) * D + sc)
#define VMW() asm volatile("s_waitcnt vmcnt(0)" ::: "memory")
#define VMWN(n) asm volatile("s_waitcnt vmcnt(%0)" :: "i"(n) : "memory")
#define SLOAD_H(Kp, Vp, k0) do { S.st_v0 = load8(ROW(Vp, k0, sr)); S.st_v1 = load8(ROW(Vp, k0, 32 + sr));              \
                         S.st_k0 = load8(ROW(Kp, k0, sr)); S.st_k1 = load8(ROW(Kp, k0, 32 + sr)); } while (0)
#define SWRITE_HK(bf) do { *(bf16x8*)(K_lds + (bf) * SHM_K + kws) = S.st_k0; *(bf16x8*)(K_lds + (bf) * SHM_K + kws + 32 * 256) = S.st_k1; } while (0)
#define SWRITE_HV(bf) do { *(bf16x8*)(V_lds + (bf) * SHM_V + vst0) = S.st_v0; *(bf16x8*)(V_lds + (bf) * SHM_V + vst1) = S.st_v1; } while (0)
#define SWRITE_H(bf) do { SWRITE_HV(bf); SWRITE_HK(bf); } while (0)
__device__ __forceinline__ void moba_prime(const BlockRef& cur, char* lds, Seam& S) {
    int tid_o = threadIdx.x; asm volatile("" : "+v"(tid_o));
    const int tid = tid_o, wid = __builtin_amdgcn_readfirstlane(tid >> 6), lane = tid & 63, r32 = lane & 31, hi = lane >> 5;
    const int sr = tid >> 4, sc = (tid & 15) * 8, kws = KSWZ(sr, sc * 2); char* K_lds = lds + 2 * SHM_V;
    for (int d0 = 0; d0 < 8; ++d0) S.qr[d0] = load8(cur.Q + (size_t)(wid * QBLK + r32) * D + d0 * 16 + hi * 8);
    SLOAD_H(cur.K, cur.V, 0); VMW(); SWRITE_HK(0);
    __syncthreads();
}
__device__ __forceinline__ unsigned moba_select(const BlockRef& cur, char* lds, const Seam& S) {
    int tid_o = threadIdx.x; asm volatile("" : "+v"(tid_o));
    const int tid = tid_o, lane = tid & 63, hi = lane >> 5;
    const int own = cur.P0 >> 8;
    float* km = (float*)(lds + LDS_KM);
    __syncthreads();
    *(f32x4*)(km + tid * 4) = *(const f32x4*)(cur.KM + tid * 4);
    __syncthreads();
    float v1 = -__builtin_inff(), v2 = v1, v3 = v1; int i1 = 31, i2 = 31, i3 = 31;
    for (int j = 0; j < own; ++j) {
        const float* kr = km + j * 128 + hi * 8; float a = 0.f;
#pragma unroll
        for (int d0 = 0; d0 < 8; ++d0) { const f32x4 k0 = *(const f32x4*)(kr + d0 * 16), k1 = *(const f32x4*)(kr + d0 * 16 + 4); const bf16x8 q = S.qr[d0];
#pragma unroll
            for (int e = 0; e < 4; ++e) { a = fmaf(__uint_as_float((unsigned)(unsigned short)q[e] << 16), k0[e], a); a = fmaf(__uint_as_float((unsigned)(unsigned short)q[4 + e] << 16), k1[e], a); } }
        const float t = a + __shfl_xor(a, 32);
        if (t > v1) { v3 = v2; i3 = i2; v2 = v1; i2 = i1; v1 = t; i1 = j; }
        else if (t > v2) { v3 = v2; i3 = i2; v2 = t; i2 = j; }
        else if (t > v3) { v3 = t; i3 = j; }
    }
    return ((1u << i1) | (1u << i2) | (1u << i3)) & 0xffffu;
}
__device__ __forceinline__ void moba_block(const BlockRef& cur, const BlockRef& nxt, unsigned sel, char* lds, Seam& S) {
    int tid_o = threadIdx.x; asm volatile("" : "+v"(tid_o));
    const int tid = tid_o, wid = __builtin_amdgcn_readfirstlane(tid >> 6), lane = tid & 63, r32 = lane & 31, hi = lane >> 5;
    const int NT = cur.P0 / KVBLK + 4;
    const int qlo = cur.P0 + wid * QBLK, qm = qlo + r32 - 4 * hi;
    char* V_lds = lds; char* K_lds = lds + 2 * SHM_V;
    float* ws = (float*)(lds + LDS_WS) + wid * 64; float* li_l = ws, * al_l = ws + 32;
    float m_reg = -1e30f, l_reg = 0; f32x16 o[4] = {};
    const int sr = tid >> 4, sc = (tid & 15) * 8, vst0 = v_st(sr, sc), vst1 = v_st(32 + sr, sc), kws = KSWZ(sr, sc * 2);
    const int vb0 = (int)(uintptr_t)V_lds + v_rd_base(lane);
    const bf16* Kh = cur.K; const bf16* Vh = cur.V;
#define RESC(a) do { if (__any((a) < 1.f)) { if (hi == 0) al_l[r32] = (a); asm volatile("s_waitcnt lgkmcnt(0)" ::: "memory");              \
                     for (int d_ = 0; d_ < 4; ++d_) for (int r = 0; r < 16; ++r) o[d_][r] *= al_l[crow(r, hi)]; } } while (0)
#define KBASE(t) ((t) * KVBLK)
#define MASKT(P0_, P1_, t) do { const int kb_ = KBASE(t); \
        if (kb_ < cur.P0) { const bool keep_ = ((sel >> (kb_ >> 8)) & 1u) != 0u; if (!__all(keep_)) mask_all(P0_, P1_, keep_); } \
        else if (kb_ + KVBLK - 1 > qlo) mask_tile(P0_, P1_, qm - kb_); } while (0)
    constexpr int NQL = 8;
#define SEAM_K0() do { VMWN(NQL); SWRITE_HK(0); SBAR(); } while (0)
    f32x16 pA0, pA1, pB0, pB1; float mnA, mnB, alA, alB; bf16x8 pa0, pa1, pa2, pa3;
    SWRITE_HV(0); SBAR();
    SLOAD_H(Kh, Vh, KBASE(1));
    SBAR(); qkt<0>(pA0, pA1, K_lds, r32, hi, S.qr);
    MASKT(pA0, pA1, 0); partialSM(pA0, pA1, m_reg, mnA, alA);
    VMW(); SWRITE_H(1);
    __syncthreads();
#define HALF_STEP(PX0, PX1, mnX, alX, PY0, PY1, alY, t, KB, VB, SB) do {                                                      \
        SBAR(); qkt<KB>(PX0, PX1, K_lds, r32, hi, S.qr);                                             \
        finishSM(PY0, PY1, alY, l_reg, pa0, pa1, pa2, pa3); SBAR();                                                           \
        if ((t) + 1 < NT) { SLOAD_H(Kh, Vh, KBASE((t) + 1)); SBAR(); }                                               \
        pv_tile<VB>(o, vb0, pa0, pa1, pa2, pa3); MASKT(PX0, PX1, (t)); partialSM(PX0, PX1, m_reg, mnX, alX);                                        \
        __syncthreads();                                                                                                      \
        if ((t) + 1 < NT) { VMW(); SWRITE_H(SB); }                                                                          \
        RESC(alX); __syncthreads(); } while (0)
    for (int t = 1; t + 1 < NT; t += 2) {
        HALF_STEP(pB0, pB1, mnB, alB, pA0, pA1, alA, t, 1, 0, 0);
        HALF_STEP(pA0, pA1, mnA, alA, pB0, pB1, alB, t + 1, 0, 1, 1);
    }
    { SBAR(); qkt<1>(pB0, pB1, K_lds, r32, hi, S.qr); SBAR(); }
    SLOAD_H(nxt.K, nxt.V, 0); SBAR();
#pragma unroll
    for (int d0 = 0; d0 < 8; ++d0) S.qr[d0] = load8(nxt.Q + (size_t)(wid * QBLK + r32) * D + d0 * 16 + hi * 8);
    SBAR();
    finishSM(pA0, pA1, alA, l_reg, pa0, pa1, pa2, pa3); SBAR();
    pv_tile<0>(o, vb0, pa0, pa1, pa2, pa3);
    { MASKT(pB0, pB1, NT - 1); partialSM(pB0, pB1, m_reg, mnB, alB); __syncthreads(); RESC(alB);
      finishSM(pB0, pB1, alB, l_reg, pa0, pa1, pa2, pa3); SBAR(); pv_tile<1>(o, vb0, pa0, pa1, pa2, pa3); }
    SBAR(); SEAM_K0();
    if (hi == 0) li_l[r32] = l_reg; asm volatile("s_waitcnt lgkmcnt(0)" ::: "memory");
    float rli[16];
#pragma unroll
    for (int r = 0; r < 16; ++r) rli[r] = __builtin_amdgcn_rcpf(li_l[crow(r, hi)]);
    char* Ow = (char*)(cur.O + (size_t)(wid * QBLK) * OPITCH);
    unsigned obase = (unsigned)(hi * 4 * OPITCH + r32) * 2u; asm volatile("" : "+v"(obase));
#pragma unroll
    for (int r = 0; r < 16; ++r) { const int orow = crow(r, hi); float ss = 0.f; const unsigned off = obase + (unsigned)(((r & 3) + 8 * (r >> 2)) * OPITCH * 2);
#pragma unroll
        for (int d0 = 0; d0 < 4; ++d0) { const float v = o[d0][r] * rli[r]; ss = fmaf(v, v, ss);
            const float vn = __shfl_xor(v, 1);
            if ((r32 & 1) == 0) *(unsigned*)(Ow + off + d0 * 64) = cvtpk(v, vn); }
        ss += __shfl_xor(ss, 1); ss += __shfl_xor(ss, 2); ss += __shfl_xor(ss, 4); ss += __shfl_xor(ss, 8); ss += __shfl_xor(ss, 16);
        if (r32 == 0) cur.SS[wid * QBLK + orow] = ss; }
    __syncthreads();
#undef RESC
#undef KBASE
#undef MASKT
#undef SEAM_K0
#undef HALF_STEP
}
#undef ROW
#undef VMW
#undef VMWN
#undef SLOAD_H
#undef SWRITE_HK
#undef SWRITE_HV
#undef SWRITE_H
#undef KSWZ
#undef SBAR
}

constexpr int NWAVES = 8;
#ifndef MK_N_LAUNCHES
#define MK_N_LAUNCHES 1
#endif
constexpr int N_PHASES = 11;
constexpr int N_LAUNCHES = MK_N_LAUNCHES;
static_assert(N_LAUNCHES == 1 || N_LAUNCHES == N_PHASES, "MK_N_LAUNCHES is 1 or 11");

constexpr int BATCH = 4, SEQ = 4096, DM = 2048, M = BATCH * SEQ;
constexpr int NH = 8, HD = 128, AW = 1024, RW = 1024, NRB = 16, RBD = 64;
constexpr int INC = 5120, DFF = 5504, NGU = 2 * DFF;
constexpr float EPS = 1e-6f;

constexpr size_t MiB = 1u << 20;
constexpr size_t WS_CTL = 0, CTL_ZERO_BYTES = 1 * MiB;
constexpr size_t WS_KMEAN = 512 * 1024;
constexpr size_t WS_ROPE = 1 * MiB;
constexpr size_t WS_SSA = 2 * MiB;
constexpr size_t WS_SSR = 3 * MiB;
constexpr size_t WS_WGU1 = 8 * MiB;
constexpr size_t WS_WD1 = 51 * MiB;
constexpr size_t WS_WIN = 73 * MiB;
constexpr size_t WS_WOUT = 93 * MiB;
constexpr size_t WS_WGU2 = 101 * MiB;
constexpr size_t WS_WD2 = 144 * MiB;
constexpr size_t WS_H = 166 * MiB;
constexpr size_t WS_ACT = 230 * MiB;
constexpr size_t WS_END = 402 * MiB;
static_assert(true, "");
constexpr size_t ACT_Q = 0, ACT_K = 32 * MiB, ACT_V = 64 * MiB, ACT_XR = 96 * MiB, ACT_GR = 128 * MiB;
static_assert(WS_WGU1 + (size_t)NGU * DM * 2 <= WS_WD1 && WS_WD1 + (size_t)DM * DFF * 2 <= WS_WIN && WS_WIN + (size_t)INC * DM * 2 <= WS_WOUT && WS_WOUT + (size_t)DM * DM * 2 <= WS_WGU2 &&
              WS_WGU2 + (size_t)NGU * DM * 2 <= WS_WD2 && WS_WD2 + (size_t)DM * DFF * 2 <= WS_H && WS_H + (size_t)M * DM * 2 <= WS_ACT && WS_ACT + (size_t)M * DFF * 2 <= WS_END, "d_ws map");
constexpr int CW_TMO = 0, CW_CODE = 1, CW_BAR = 4096;

constexpr int RING_OFF = 0, RING_BYTES = 131072;
constexpr int LDSCTL_OFF = RING_BYTES, MISC_OFF = LDSCTL_OFF + 320, SCL_OFF = LDSCTL_OFF + 1024;
constexpr int LDS_BYTES = 147456;
static_assert(SCL_OFF + 8192 <= LDS_BYTES && moba::LDS_BYTES <= RING_BYTES, "LDS map");

#define GAS __attribute__((address_space(1)))
#define LAS __attribute__((address_space(3)))
typedef unsigned short bf16;
typedef unsigned v4u __attribute__((ext_vector_type(4)));
typedef float f32x4 __attribute__((ext_vector_type(4)));
typedef short bf16x8 __attribute__((ext_vector_type(8)));
typedef GAS unsigned gu32;
typedef GAS unsigned long long gu64;
#define RLX_AGENT __ATOMIC_RELAXED, __HIP_MEMORY_SCOPE_AGENT
#define LDS_WAIT() asm volatile("s_waitcnt lgkmcnt(0)" ::: "memory")
#define VM_WAIT() asm volatile("s_waitcnt vmcnt(0)" ::: "memory")
__device__ __forceinline__ unsigned long long rt() { return __builtin_amdgcn_s_memrealtime(); }
__device__ __forceinline__ unsigned f2bf(float f) { unsigned u = __builtin_bit_cast(unsigned, f); return (u + 0x7fffu + ((u >> 16) & 1u)) >> 16; }
__device__ __forceinline__ unsigned pk2(float lo, float hi) { return f2bf(lo) | (f2bf(hi) << 16); }

#define XB_TMO      128
#define XB_XCNT(j)  (256  + 64 * (j))
#define XB_XSUB(j)  (1280 + 64 * (j))
#define XB_XGEN(j)  (2304 + 64 * (j))
#define XB_TOP      3328
#define XB_TOPGEN   3392
#define XCD_BAR_WORDS 3456
#define XB_SPIN_CAP (1u << 18)

__device__ __forceinline__ unsigned xb_ld(unsigned* p)              { return __hip_atomic_load(p, __ATOMIC_RELAXED, __HIP_MEMORY_SCOPE_AGENT); }
__device__ __forceinline__ unsigned xb_add(unsigned* p, unsigned v) { return __hip_atomic_fetch_add(p, v, __ATOMIC_RELAXED, __HIP_MEMORY_SCOPE_AGENT); }
__device__ __forceinline__ unsigned xb_xcc_id() { return (unsigned)__builtin_amdgcn_s_getreg((3 << 11) | 20) & 0xFu; }
#define XB_SPIN(cond, bar) do { unsigned _sp = 0; while (cond) { __builtin_amdgcn_s_sleep(1); \
    if ((++_sp & 255u) == 0u) { if (xb_ld(&(bar)[XB_TMO])) break; if (_sp > XB_SPIN_CAP) { atomicAdd(&(bar)[XB_TMO], 1u); break; } } } } while (0)

struct XcdBarrier {
    unsigned* bar; unsigned x;
    volatile LAS unsigned* st;
};

__device__ __forceinline__ XcdBarrier xcd_barrier_post(unsigned* bar, volatile LAS unsigned* st) {
    XcdBarrier b; b.bar = bar; b.x = xb_xcc_id(); b.st = st;
    if (threadIdx.x == 0) (void)xb_add(&bar[XB_XCNT(b.x)], 1u);
    return b;
}
__device__ __forceinline__ void xcd_barrier_complete(unsigned* bar, unsigned x, unsigned& nloc, unsigned& nx) {
    const unsigned G = gridDim.x * gridDim.y * gridDim.z;
    unsigned sum, cnt, mine, sp = 0u;
    for (;;) {
        sum = 0u; cnt = 0u; mine = 0u;
#pragma unroll
        for (unsigned j = 0; j < 16; ++j) { const unsigned c = xb_ld(&bar[XB_XCNT(j)]); sum += c; cnt += (c > 0u) ? 1u : 0u; mine = (j == x) ? c : mine; }
        if (sum == G) break;
        __builtin_amdgcn_s_sleep(1);
        if ((++sp & 255u) == 0u) { if (xb_ld(&bar[XB_TMO])) break; if (sp > XB_SPIN_CAP) { atomicAdd(&bar[XB_TMO], 1u); break; } }
    }
    nloc = mine > 0u ? mine : 1u; nx = cnt > 0u ? cnt : 1u;
}

__device__ __forceinline__ void xcd_barrier(const XcdBarrier& b) {
    asm volatile("s_waitcnt vmcnt(0)" ::: "memory");
    __syncthreads();
    if (threadIdx.x == 0) {
        unsigned* bar = b.bar;
        __builtin_amdgcn_s_waitcnt(0);
        unsigned nloc = b.st[0], nx = b.st[1];
        if (nloc == 0u) { xcd_barrier_complete(bar, b.x, nloc, nx); b.st[0] = nloc; b.st[1] = nx; }
        const unsigned old = xb_add(&bar[XB_XSUB(b.x)], 1u);
        const unsigned gen = old / nloc;
        if (old + 1u == (gen + 1u) * nloc) {
            __builtin_amdgcn_fence(__ATOMIC_RELEASE, "agent");
            asm volatile("s_waitcnt vmcnt(0)" ::: "memory");
            const unsigned og = xb_add(&bar[XB_TOP], 1u);
            const unsigned tg = og / nx;
            if (og + 1u == (tg + 1u) * nx) xb_add(&bar[XB_TOPGEN], 1u);
            else XB_SPIN(xb_ld(&bar[XB_TOPGEN]) == tg, bar);
            __builtin_amdgcn_fence(__ATOMIC_ACQUIRE, "agent");
            xb_add(&bar[XB_XGEN(b.x)], 1u);
            asm volatile("s_waitcnt vmcnt(0)" ::: "memory");
        } else {
            XB_SPIN(xb_ld(&bar[XB_XGEN(b.x)]) == gen, bar);
            __builtin_amdgcn_fence(__ATOMIC_ACQUIRE, "agent");
            asm volatile("s_waitcnt vmcnt(0)" ::: "memory");
        }
    }
    __syncthreads();
}

struct Frame {
    LAS unsigned char* lds;
    volatile LAS unsigned* MISC;
    gu32* ctl;
    int vcu, G;
};
__device__ __forceinline__ float wave_sum(float v) {
#pragma unroll
    for (int o = 1; o < 64; o <<= 1) v += __shfl_xor(v, o);
    return v;
}
__device__ __forceinline__ float bf2f(unsigned short b) { return __uint_as_float((unsigned)b << 16); }
__device__ __forceinline__ void transpose_item(const float* W, int N, int Kd, bf16* WT, int k0, int n0, int drow0, const float* ksc, LAS float* scr, int lane) {
#pragma unroll 8
    for (int i = 0; i < 32; ++i) { const int kk = 2 * i + (lane >> 5); float v = W[(size_t)(k0 + kk) * N + n0 + (lane & 31)]; if (ksc) v *= ksc[k0 + kk]; scr[kk * 33 + (lane & 31)] = v; }
    LDS_WAIT(); asm volatile("" ::: "memory");
    const int c = lane & 7;
#pragma unroll
    for (int j = 0; j < 4; ++j) { const int n = (lane >> 3) + 8 * j; const LAS float* s = scr + (8 * c) * 33 + n;
        v4u o; o.x = pk2(s[0 * 33], s[1 * 33]); o.y = pk2(s[2 * 33], s[3 * 33]); o.z = pk2(s[4 * 33], s[5 * 33]); o.w = pk2(s[6 * 33], s[7 * 33]);
        *(GAS v4u*)(WT + (size_t)(drow0 + n) * Kd + k0 + 8 * c) = o; }
    LDS_WAIT(); asm volatile("" ::: "memory");
}
__device__ __forceinline__ void transpose_matrix(Frame& F, const float* W, int K, int N, bf16* WT, int Kd, const float* ksc, bool gu, LAS float* scr, int gw0, int NGW) {
    const int nblk = N / 32, nitems = (K / 64) * nblk;
    for (int it = gw0; it < nitems; it += NGW) { const int kb = it / nblk, nb = it - kb * nblk, n0 = 32 * nb; int drow0 = n0;
        if (gu) { const int half = n0 >= DFF, nn = n0 - half * DFF; drow0 = 256 * (nn >> 7) + 128 * half + (nn & 127); }
        transpose_item(W, N, Kd, WT, 64 * kb, n0, drow0, ksc, scr, ((int)threadIdx.x & 63)); }
}
__device__ __forceinline__ void sincos_tab(double a, float& c, float& s) {
    const double k = rint(a * 0.15915494309189535); double r = fma(-k, 6.283185307179586, a); r = fma(-k, 2.4492935982947064e-16, r);
    const double r2 = r * r; double sv = 1.0, cv = 1.0;
#pragma unroll
    for (int n = 14; n >= 1; --n) { sv = 1.0 - r2 * sv / (double)((2 * n) * (2 * n + 1)); cv = 1.0 - r2 * cv / (double)((2 * n - 1) * (2 * n)); }
    s = (float)(r * sv); c = (float)cv;
}
__device__ __forceinline__ void rms_rows(Frame& F, const float* x, const float* g, bf16* hout) {
    const int gw = F.vcu * NWAVES + __builtin_amdgcn_readfirstlane((int)threadIdx.x >> 6), NGW = F.G * NWAVES;
    f32x4 gv[8];
#pragma unroll
    for (int i = 0; i < 8; ++i) gv[i] = *(const f32x4*)(g + 256 * i + 4 * ((int)threadIdx.x & 63));
    for (int m = gw; m < M; m += NGW) {
        const float* xr = x + (size_t)m * DM + 4 * ((int)threadIdx.x & 63); f32x4 v[8]; float s = 0.f;
#pragma unroll
        for (int i = 0; i < 8; ++i) { v[i] = *(const f32x4*)(xr + 256 * i); s += (v[i].x * v[i].x + v[i].y * v[i].y) + (v[i].z * v[i].z + v[i].w * v[i].w); }
        const float rs = 1.0f / sqrtf(wave_sum(s) * (1.0f / DM) + EPS);
        bf16* ho = hout + (size_t)m * DM + 4 * ((int)threadIdx.x & 63);
#pragma unroll
        for (int i = 0; i < 8; ++i) { const f32x4 o = v[i] * rs * gv[i]; *(unsigned long long*)(ho + 256 * i) = (unsigned long long)pk2(o.x, o.y) | ((unsigned long long)pk2(o.z, o.w) << 32); }
    }
}
template <bool HAS_H>
__device__ __forceinline__ void norm_res_rows(Frame& F, const bf16* src, const float* base, float* out, bf16* hout, const float* gpost, const float* gpre, float alpha) {
    const int gw = F.vcu * NWAVES + __builtin_amdgcn_readfirstlane((int)threadIdx.x >> 6), NGW = F.G * NWAVES;
    f32x4 gp[8], gq[8];
#pragma unroll
    for (int i = 0; i < 8; ++i) { gp[i] = *(const f32x4*)(gpost + 256 * i + 4 * ((int)threadIdx.x & 63)) * alpha; if (HAS_H) gq[i] = *(const f32x4*)(gpre + 256 * i + 4 * ((int)threadIdx.x & 63)); }
    for (int m = gw; m < M; m += NGW) {
        const bf16* sr = src + (size_t)m * DM + 4 * ((int)threadIdx.x & 63); const float* br = base + (size_t)m * DM + 4 * ((int)threadIdx.x & 63);
        f32x4 f[8], x[8]; float s = 0.f;
#pragma unroll
        for (int i = 0; i < 8; ++i) { const unsigned long long w = *(const unsigned long long*)(sr + 256 * i); x[i] = *(const f32x4*)(br + 256 * i);
            f[i] = (f32x4){__uint_as_float((unsigned)w << 16), __uint_as_float((unsigned)w & 0xffff0000u), __uint_as_float((unsigned)(w >> 32) << 16), __uint_as_float((unsigned)(w >> 32) & 0xffff0000u)};
            s += (f[i].x * f[i].x + f[i].y * f[i].y) + (f[i].z * f[i].z + f[i].w * f[i].w); }
        const float rs = 1.0f / sqrtf(wave_sum(s) * (1.0f / DM) + EPS);
        float* orow = out + (size_t)m * DM + 4 * ((int)threadIdx.x & 63); float s1 = 0.f;
#pragma unroll
        for (int i = 0; i < 8; ++i) { x[i] = x[i] + f[i] * rs * gp[i]; *(f32x4*)(orow + 256 * i) = x[i]; s1 += (x[i].x * x[i].x + x[i].y * x[i].y) + (x[i].z * x[i].z + x[i].w * x[i].w); }
        if (HAS_H) {
            const float rs1 = 1.0f / sqrtf(wave_sum(s1) * (1.0f / DM) + EPS);
            bf16* ho = hout + (size_t)m * DM + 4 * ((int)threadIdx.x & 63);
#pragma unroll
            for (int i = 0; i < 8; ++i) { const f32x4 o = x[i] * rs1 * gq[i]; *(unsigned long long*)(ho + 256 * i) = (unsigned long long)pk2(o.x, o.y) | ((unsigned long long)pk2(o.z, o.w) << 32); }
        }
    }
}

struct RecArgs { const bf16* XR; const bf16* GR; bf16* OUT  ; float* SSR  ;
                 const float *conv_w, *conv_b, *w_a, *b_a, *w_x, *b_x, *lam; };
__device__ __forceinline__ float sigmoidf_(float x) { return __builtin_amdgcn_rcpf(1.0f + __builtin_amdgcn_exp2f(-1.4426950408889634f * x)); }
__device__ __forceinline__ void rec_unit(Frame& F, const RecArgs& R, int b, int nb, int qq) {
    typedef float f32x4v __attribute__((ext_vector_type(4)));
    const int lane = ((int)threadIdx.x & 63), wave = __builtin_amdgcn_readfirstlane((int)threadIdx.x >> 6), c = lane & 15, q = lane >> 4;
    const int ch = 64 * nb + 16 * qq + c;
    LAS float* cwl = (LAS float*)(F.lds + RING_OFF);
    LAS float* sum = (LAS float*)(F.lds + RING_OFF + 2048);
    __syncthreads();
    if (((int)threadIdx.x) < 256) cwl[((int)threadIdx.x)] = R.conv_w[(((int)threadIdx.x) >> 6) * RW + 64 * nb + (((int)threadIdx.x) & 63)]; else if (((int)threadIdx.x) < 320) cwl[((int)threadIdx.x)] = R.conv_b[64 * nb + (((int)threadIdx.x) - 256)];
    bf16x8 ba[2], bx[2];
#pragma unroll
    for (int ks = 0; ks < 2; ++ks)
#pragma unroll
        for (int e = 0; e < 8; ++e) { const size_t wi = ((size_t)nb * 64 + 32 * ks + 8 * q + e) * 64 + 16 * qq + c; ba[ks][e] = (short)f2bf(R.w_a[wi]); bx[ks][e] = (short)f2bf(R.w_x[wi]); }
    const float bac = R.b_a[ch], bxc = R.b_x[ch];
    const float lamv = R.lam[ch]; const float sp8 = -8.0f * log1pf(expf(-lamv)) * 1.4426950408889634f;
    const float cw0 = R.conv_w[ch], cw1 = R.conv_w[RW + ch], cw2 = R.conv_w[2 * RW + ch], cw3 = R.conv_w[3 * RW + ch], cbc = R.conv_b[ch];
    __syncthreads();
    float carry = 0.f;
    const int slot = nb * 4 + qq;
    for (int chunk = 0; chunk < 16; ++chunk) {
        const int tb = chunk * 256 + wave * 32;
        const size_t rowb = (size_t)b * SEQ + tb;
        bf16x8 af[2][2];
#pragma unroll
        for (int mt = 0; mt < 2; ++mt)
#pragma unroll
            for (int ks = 0; ks < 2; ++ks) { const int tok = tb + 16 * mt + c, cl = 32 * ks + 8 * q;
                float xc[8];
#pragma unroll
                for (int e = 0; e < 8; ++e) xc[e] = cwl[256 + cl + e];
#pragma unroll
                for (int tap = 0; tap < 4; ++tap) { const int tt = tok - 3 + tap;
                    v4u w = (v4u){0u, 0u, 0u, 0u}; if (tt >= 0) w = *(const v4u*)(R.XR + ((size_t)b * SEQ + tt) * RW + 64 * nb + cl);
                    const unsigned ww[4] = {w.x, w.y, w.z, w.w};
#pragma unroll
                    for (int e = 0; e < 4; ++e) { xc[2 * e] = fmaf(cwl[tap * 64 + cl + 2 * e], __uint_as_float(ww[e] << 16), xc[2 * e]); xc[2 * e + 1] = fmaf(cwl[tap * 64 + cl + 2 * e + 1], __uint_as_float(ww[e] & 0xffff0000u), xc[2 * e + 1]); } }
                v4u p; p.x = pk2(xc[0], xc[1]); p.y = pk2(xc[2], xc[3]); p.z = pk2(xc[4], xc[5]); p.w = pk2(xc[6], xc[7]);
                af[mt][ks] = __builtin_bit_cast(bf16x8, p); }
        f32x4v gr_[2], gi_[2];
#pragma unroll
        for (int mt = 0; mt < 2; ++mt) { f32x4v z = {0.f, 0.f, 0.f, 0.f};
            gr_[mt] = __builtin_amdgcn_mfma_f32_16x16x32_bf16(af[mt][0], ba[0], z, 0, 0, 0); gr_[mt] = __builtin_amdgcn_mfma_f32_16x16x32_bf16(af[mt][1], ba[1], gr_[mt], 0, 0, 0);
            gi_[mt] = __builtin_amdgcn_mfma_f32_16x16x32_bf16(af[mt][0], bx[0], z, 0, 0, 0); gi_[mt] = __builtin_amdgcn_mfma_f32_16x16x32_bf16(af[mt][1], bx[1], gi_[mt], 0, 0, 0); }
        float av[2][4], uv[2][4], P[2], Hs[2];
#pragma unroll
        for (int mt = 0; mt < 2; ++mt) { const int t0 = tb + 16 * mt + 4 * q;
            float xs[7];
#pragma unroll
            for (int i = 0; i < 7; ++i) { const int tt = t0 - 3 + i; xs[i] = tt >= 0 ? bf2f(R.XR[((size_t)b * SEQ + tt) * RW + ch]) : 0.f; }
#pragma unroll
            for (int j = 0; j < 4; ++j) { const float xcv = fmaf(cw3, xs[j + 3], fmaf(cw2, xs[j + 2], fmaf(cw1, xs[j + 1], fmaf(cw0, xs[j], cbc))));
                const float r = sigmoidf_(gr_[mt][j] + bac), ig = sigmoidf_(gi_[mt][j] + bxc);
                const float a = __builtin_amdgcn_exp2f(r * sp8); av[mt][j] = a; uv[mt][j] = sqrtf(fmaxf(1.0f - a * a, 0.f)) * (ig * xcv); }
            P[mt] = (av[mt][0] * av[mt][1]) * (av[mt][2] * av[mt][3]);
            Hs[mt] = fmaf(fmaf(fmaf(uv[mt][0], av[mt][1], uv[mt][1]), av[mt][2], uv[mt][2]), av[mt][3], uv[mt][3]); }
        float Ps[8], Hh[8];
#pragma unroll
        for (int mt = 0; mt < 2; ++mt)
#pragma unroll
            for (int qq2 = 0; qq2 < 4; ++qq2) { Ps[4 * mt + qq2] = __shfl(P[mt], c + 16 * qq2); Hh[4 * mt + qq2] = __shfl(Hs[mt], c + 16 * qq2); }
        float Pw = 1.f, Hw = 0.f;
#pragma unroll
        for (int s = 0; s < 8; ++s) { Hw = fmaf(Ps[s], Hw, Hh[s]); Pw *= Ps[s]; }
        LAS float* sb = sum + (chunk & 1) * 256;
        if (q == 0) { sb[(wave * 16 + c) * 2] = Pw; sb[(wave * 16 + c) * 2 + 1] = Hw; }
        __syncthreads();
        float st = carry, cn = carry;
#pragma unroll
        for (int w2 = 0; w2 < 8; ++w2) { const float pw = sb[(w2 * 16 + c) * 2], hw = sb[(w2 * 16 + c) * 2 + 1]; cn = fmaf(pw, cn, hw); if (w2 < wave) st = cn; }
        carry = cn;
        float sin_[2];
#pragma unroll
        for (int s = 0; s < 8; ++s) { if ((s & 3) == q) sin_[s >> 2] = st; st = fmaf(Ps[s], st, Hh[s]); }
#pragma unroll
        for (int mt = 0; mt < 2; ++mt) { const int t0 = tb + 16 * mt + 4 * q; float h = sin_[mt]; f32x4v ss;
#pragma unroll
            for (int j = 0; j < 4; ++j) { h = fmaf(av[mt][j], h, uv[mt][j]);
                const size_t row = (size_t)b * SEQ + t0 + j;
                const float g = bf2f(R.GR[row * RW + ch]); const float z = 1.5957691216057308f * (g + 0.044715f * g * g * g);
                const float o = h * g * sigmoidf_(z);
                R.OUT[row * (size_t)DM + AW + ch] = (bf16)f2bf(o);
                float s2 = o * o; s2 += __shfl_xor(s2, 1); s2 += __shfl_xor(s2, 2); s2 += __shfl_xor(s2, 4); s2 += __shfl_xor(s2, 8); ss[j] = s2; }
            if (c == 0) *(f32x4v*)(R.SSR + (size_t)slot * M + (size_t)b * SEQ + t0) = ss; }
        (void)rowb;
    }
}

struct Args { const float* in[22]; float* out; unsigned char* ws; double invf[16]; int ph_lo, ph_hi, li, pad; };
__global__ void __launch_bounds__(NWAVES * 64, 2) hyb_fwd(Args args) {
    extern __shared__ __attribute__((aligned(16))) unsigned char lds[];
    Frame F;
    F.lds = (LAS unsigned char*)lds;
    F.MISC = (volatile LAS unsigned*)(F.lds + MISC_OFF);
    F.G = gridDim.x; { const int bx = blockIdx.x; F.vcu = (F.G % 8 == 0) ? (bx % 8) * (F.G / 8) + bx / 8 : bx; }
    unsigned char* ws = args.ws;
    F.ctl = (gu32*)(ws + WS_CTL);
#define GRID_BAR(seam) do { if (N_LAUNCHES != 1) { if (((int)threadIdx.x) == 0) __hip_atomic_store(F.ctl + CW_TMO, 0xBADBA0u | (unsigned)(seam), RLX_AGENT); } else { xcd_barrier(bar); } } while (0)
    const float* x = args.in[0];
    bf16* Wgu1 = (bf16*)(ws + WS_WGU1); bf16* Wd1 = (bf16*)(ws + WS_WD1); bf16* Win = (bf16*)(ws + WS_WIN); bf16* Wout = (bf16*)(ws + WS_WOUT);
    bf16* Wgu2 = (bf16*)(ws + WS_WGU2); bf16* Wd2 = (bf16*)(ws + WS_WD2);
    bf16* H = (bf16*)(ws + WS_H); bf16* ACT = (bf16*)(ws + WS_ACT);
    bf16* Qh = (bf16*)(ws + WS_ACT + ACT_Q); bf16* Kh = (bf16*)(ws + WS_ACT + ACT_K); bf16* Vh = (bf16*)(ws + WS_ACT + ACT_V);
    bf16* XR = (bf16*)(ws + WS_ACT + ACT_XR); bf16* GR = (bf16*)(ws + WS_ACT + ACT_GR); bf16* Y = (bf16*)(ws + WS_ACT);
    float* rope = (float*)(ws + WS_ROPE); float* kmean = (float*)(ws + WS_KMEAN); float* ssa = (float*)(ws + WS_SSA); float* ssr = (float*)(ws + WS_SSR);
    float* out = args.out;
    for (int u = ((int)threadIdx.x); u < (LDS_BYTES - LDSCTL_OFF) / 4; u += NWAVES * 64) ((LAS unsigned*)(F.lds + LDSCTL_OFF))[u] = 0u;
    __syncthreads();
    XcdBarrier bar; bar.bar = (unsigned*)(F.ctl + CW_BAR); bar.x = 0; bar.st = nullptr;
    if (N_LAUNCHES == 1) bar = xcd_barrier_post((unsigned*)(F.ctl + CW_BAR), F.MISC + 8);
    const int lo = args.ph_lo, hi = args.ph_hi;
#ifndef PH_MASK
#define PH_MASK 0x7ff
#endif
#define IN(k) ((((PH_MASK) >> (k)) & 1) && lo <= (k) && (k) < hi)
#define BOTH(k) (IN(k) && IN((k) + 1))

    if (IN(0)) {
        LAS float* scr = (LAS float*)(F.lds + RING_OFF + __builtin_amdgcn_readfirstlane((int)threadIdx.x >> 6) * 16384);
        const int gw = F.vcu * NWAVES + __builtin_amdgcn_readfirstlane((int)threadIdx.x >> 6), NGW = F.G * NWAVES;
        for (int i = blockIdx.x * (NWAVES * 64) + ((int)threadIdx.x); i < SEQ * 16; i += F.G * NWAVES * 64) { float c, s; sincos_tab((double)(i >> 4) * args.invf[i & 15], c, s); rope[2 * i] = c; rope[2 * i + 1] = s; }
        rms_rows(F, x, args.in[1], H);
        transpose_matrix(F, args.in[2], DM, NGU, Wgu1, DM, nullptr, true, scr, gw, NGW);
        transpose_matrix(F, args.in[3], DFF, DM, Wd1, DFF, nullptr, false, scr, gw, NGW);
        transpose_matrix(F, args.in[6], DM, INC, Win, DM, nullptr, false, scr, gw, NGW);
        transpose_matrix(F, args.in[16], AW, DM, Wout, DM, args.in[14], false, scr, gw, NGW);
        transpose_matrix(F, args.in[16] + (size_t)AW * DM, RW, DM, Wout + AW, DM, args.in[15], false, scr, gw, NGW);
        transpose_matrix(F, args.in[19], DM, NGU, Wgu2, DM, nullptr, true, scr, gw, NGW);
        transpose_matrix(F, args.in[20], DFF, DM, Wd2, DFF, nullptr, false, scr, gw, NGW);
        if (BOTH(0)) GRID_BAR(0);
    }
    if (IN(1)) {
        pg8::Gemm g{H, Wgu1, M, NGU, DM}; pg8::StaticOrder S; S.init(M, NGU, F.G, (int)blockIdx.x);
        pg8::EpiSwiGLU E{ACT, DFF};
        pg8::gemm_phase<pg8::EpiSwiGLU, pg8::StaticOrder, pg8::NoMid, true, true>(F.lds + RING_OFF, g, S, E, pg8::NoMid{});
        if (BOTH(1)) GRID_BAR(1);
    }
    if (IN(2)) {
        pg8::Gemm g{ACT, Wd1, M, DM, DFF}; pg8::StaticOrder S; S.init(M, DM, F.G, (int)blockIdx.x);
        pg8::EpiBf16 E{H, DM};
        pg8::gemm_phase<pg8::EpiBf16, pg8::StaticOrder, pg8::NoMid, true, true>(F.lds + RING_OFF, g, S, E, pg8::NoMid{});
        if (BOTH(2)) GRID_BAR(2);
    }
    if (IN(3)) {
        norm_res_rows<true>(F, H, x, out, H, args.in[4], args.in[5], 0.5f);
        if (BOTH(3)) GRID_BAR(3);
    }
    if (IN(4)) {
        pg8::Gemm g{H, Win, M, INC, DM}; pg8::StaticOrder S; S.init(M, INC, F.G, (int)blockIdx.x);
        pg8::EpiProj E{ws + WS_ACT, rope, kmean};
        pg8::gemm_phase<pg8::EpiProj, pg8::StaticOrder, pg8::NoMid, true, true>(F.lds + RING_OFF, g, S, E, pg8::NoMid{});
        if (BOTH(4)) GRID_BAR(4);
    }
    if (IN(5)) {
        char* al = (char*)lds + RING_OFF;
#ifndef NO_ATT
        for (int L = blockIdx.x; L < BATCH * NH * 8; L += F.G) {
            const int bh = L >> 3, y = L & 7, b = bh >> 3, h = bh & 7;
            const bf16* qb = Qh + (size_t)bh * SEQ * HD; const bf16* kb = Kh + (size_t)bh * SEQ * HD; const bf16* vb = Vh + (size_t)bh * SEQ * HD;
            moba::BlockRef r0, r1;
            r0.Q = qb + (size_t)(y * 256) * HD; r0.K = kb; r0.V = vb; r0.O = H + ((size_t)b * SEQ + y * 256) * DM + h * HD; r0.SS = ssa + (size_t)h * M + (size_t)b * SEQ + y * 256; r0.KM = kmean + (size_t)bh * 16 * 128; r0.P0 = y * 256;
            const int y1 = 15 - y;
            r1.Q = qb + (size_t)(y1 * 256) * HD; r1.K = kb; r1.V = vb; r1.O = H + ((size_t)b * SEQ + y1 * 256) * DM + h * HD; r1.SS = ssa + (size_t)h * M + (size_t)b * SEQ + y1 * 256; r1.KM = r0.KM; r1.P0 = y1 * 256;
            moba::Seam S;
            moba::moba_prime(r0, al, S);
            unsigned sel = moba::moba_select(r0, al, S);
            moba::moba_block(r0, r1, sel, al, S);
            sel = moba::moba_select(r1, al, S);
            moba::moba_block(r1, r1, sel, al, S);
            VM_WAIT(); __syncthreads();
        }
#endif
#ifndef NO_REC
        RecArgs R{XR, GR, H, ssr, args.in[7], args.in[8], args.in[9], args.in[10], args.in[11], args.in[12], args.in[13]};
        for (int L = blockIdx.x; L < BATCH * NRB * 4; L += F.G) rec_unit(F, R, L >> 6, (L >> 2) & 15, L & 3);
#endif
        if (BOTH(5)) GRID_BAR(5);
    }
    if (IN(6)) {
        pg8::Gemm g{H, Wout, M, DM, DM}; pg8::StaticOrder S; S.init(M, DM, F.G, (int)blockIdx.x);
        LAS float* scl = (LAS float*)(F.lds + SCL_OFF);
        { pg8::Unit u;
          for (int i = 0; i < 4 && S.next(i, u); ++i) if (((int)threadIdx.x) < 256) { const size_t row = (size_t)u.pm * 256 + ((int)threadIdx.x); float sa = 0.f, sr = 0.f;
#pragma unroll
              for (int hh = 0; hh < 8; ++hh) sa += ssa[(size_t)hh * M + row];
#pragma unroll 8
              for (int s = 0; s < 64; ++s) sr += ssr[(size_t)s * M + row];
              const float ra = 1.0f / sqrtf(sa * (1.0f / AW) + EPS), rr = 1.0f / sqrtf(sr * (1.0f / RW) + EPS);
              scl[(i * 256 + ((int)threadIdx.x)) * 2] = ra / rr; scl[(i * 256 + ((int)threadIdx.x)) * 2 + 1] = rr; }
          __syncthreads(); }
        pg8::EpiRowScaleBf16 E{Y, DM, (const PG8_LAS float*)scl}; pg8::MidRowScale MH{(const PG8_LAS float*)scl};
        pg8::gemm_phase<pg8::EpiRowScaleBf16, pg8::StaticOrder, pg8::MidRowScale, true, true>(F.lds + RING_OFF, g, S, E, MH);
        if (BOTH(6)) GRID_BAR(6);
    }
    if (IN(7)) {
        norm_res_rows<true>(F, Y, out, out, H, args.in[17], args.in[18], 1.0f);
        if (BOTH(7)) GRID_BAR(7);
    }
    if (IN(8)) {
        pg8::Gemm g{H, Wgu2, M, NGU, DM}; pg8::StaticOrder S; S.init(M, NGU, F.G, (int)blockIdx.x);
        pg8::EpiSwiGLU E{ACT, DFF};
        pg8::gemm_phase<pg8::EpiSwiGLU, pg8::StaticOrder, pg8::NoMid, true, true>(F.lds + RING_OFF, g, S, E, pg8::NoMid{});
        if (BOTH(8)) GRID_BAR(8);
    }
    if (IN(9)) {
        pg8::Gemm g{ACT, Wd2, M, DM, DFF}; pg8::StaticOrder S; S.init(M, DM, F.G, (int)blockIdx.x);
        pg8::EpiBf16 E{H, DM};
        pg8::gemm_phase<pg8::EpiBf16, pg8::StaticOrder, pg8::NoMid, true, true>(F.lds + RING_OFF, g, S, E, pg8::NoMid{});
        if (BOTH(9)) GRID_BAR(9);
    }
    if (IN(10)) {
        norm_res_rows<false>(F, H, out, out, nullptr, args.in[21], nullptr, 0.5f);
    }
#undef IN
#undef BOTH
}

extern "C" void kernel_launch(void* const* d_in, const int* in_sizes, int n_in, void* d_out, int out_size, void* d_ws, size_t ws_size, hipStream_t stream) {
    static int grid = 0;
    if (grid == 0) {
        if (n_in != 22 || in_sizes[0] != M * DM || out_size != M * DM || ws_size < WS_END) { fprintf(stderr, "kernel_launch: unexpected shapes (n_in %d, in0 %d, out %d, ws %zu)\n", n_in, n_in > 0 ? in_sizes[0] : -1, out_size, ws_size); grid = -1; return; }
        int dev = 0, cus = 0, per_cu = 0;
        if (hipGetDevice(&dev) != hipSuccess || hipDeviceGetAttribute(&cus, hipDeviceAttributeMultiprocessorCount, dev) != hipSuccess) { grid = -1; return; }
        if (hipFuncSetAttribute((const void*)hyb_fwd, hipFuncAttributeMaxDynamicSharedMemorySize, LDS_BYTES) != hipSuccess) { fprintf(stderr, "kernel_launch: hipFuncSetAttribute failed\n"); grid = -1; return; }
        if (hipOccupancyMaxActiveBlocksPerMultiprocessor(&per_cu, (const void*)hyb_fwd, NWAVES * 64, LDS_BYTES) != hipSuccess || per_cu < 1)
            fprintf(stderr, "kernel_launch: note: occupancy query reports %d workgroups per CU\n", per_cu);
        (void)hipGetLastError();
        grid = cus;
    }
    if (grid < 0) return;
    if (hipMemsetAsync((char*)d_ws + WS_CTL, 0, CTL_ZERO_BYTES, stream) != hipSuccess) return;
    Args a{};
    for (int i = 0; i < 22; ++i) a.in[i] = (const float*)d_in[i];
    a.out = (float*)d_out; a.ws = (unsigned char*)d_ws;
    for (int f = 0; f < 16; ++f) a.invf[f] = pow(500000.0, -(double)f / 16.0);
    for (int li = 0; li < N_LAUNCHES; ++li) {
        a.ph_lo = (N_LAUNCHES == 1) ? 0 : li; a.ph_hi = (N_LAUNCHES == 1) ? N_PHASES : li + 1; a.li = li; a.pad = 0;
        hipLaunchKernelGGL(hyb_fwd, dim3(grid), dim3(NWAVES * 64), LDS_BYTES, stream, a);
        const hipError_t le = hipPeekAtLastError();
        if (le != hipSuccess) { fprintf(stderr, "kernel_launch: launch %d failed: %s\n", li, hipGetErrorName(le)); break; }
    }
}
```

```cpp
#include <hip/hip_runtime.h>
#include <cstdio>
#include <cstdint>
#include <cmath>
namespace pg8 {
#define PG8_LAS __attribute__((address_space(3)))
typedef unsigned short bf16_t;
typedef short bf16x8 __attribute__((ext_vector_type(8)));
typedef float f32x4 __attribute__((ext_vector_type(4)));
typedef unsigned u32x4 __attribute__((ext_vector_type(4)));
constexpr int BM = 256, BK = 64, HALF = 128, HTB = HALF * BK * 2  , STAGE_BYTES = 8 * HTB, NXCD = 8, WGM = 4;

__host__ __device__ __forceinline__ int lds_byte(int r, int c) { const int st = (r >> 4) * 2 + (c >> 5), rr = r & 15, cc = c & 31, ob = rr * 64 + cc * 2; return st * 1024 + (ob ^ (((ob >> 9) & 1) << 5)); }
__host__ __device__ __forceinline__ void stage_rc(int b, int& R, int& C) { const int st = b / 1024, sb = b % 1024, swz = sb ^ (((sb >> 9) & 1) << 5); R = (st >> 1) * 16 + swz / 64; C = (st & 1) * 32 + (swz % 64) / 2; }
__host__ __device__ __forceinline__ int perm32(int rho) { const int n = rho >> 4, i = rho & 15; return 8 * (i >> 2) + 4 * n + (i & 3); }

struct Unit { int pm, pn; };
struct Gemm { const bf16_t* A; const bf16_t* Bt; int M, N, K; };

struct StaticOrder {
    int nM, nN, nwg, G, c;
    __host__ __device__ __forceinline__ void init(int M, int N, int G_, int c_) { nM = M / BM; nN = N / BM; nwg = nM * nN; G = G_; c = c_; }
    __host__ __device__ __forceinline__ bool next(int i, Unit& u) const {
        const long L = (long)i * G + c; if (L >= nwg) return false;
        int wgid = (int)L; { const int q = nwg / NXCD, r = nwg % NXCD, xcd = wgid % NXCD, off = wgid / NXCD; wgid = (xcd < r ? xcd * (q + 1) : r * (q + 1) + (xcd - r) * q) + off; }
        const int nig = WGM * nN, gid = wgid / nig, fm = gid * WGM, gsz = (nM - fm) < WGM ? (nM - fm) : WGM;
        u.pm = fm + ((wgid % nig) % gsz); u.pn = (wgid % nig) / gsz; return true;
    }
    __device__ __forceinline__ void a_ready(const Unit&) const {}
    __device__ __forceinline__ void done(const Unit&) const {}
};

__device__ __forceinline__ unsigned cvt_pk_bf16(float lo, float hi) { unsigned r; asm volatile("v_cvt_pk_bf16_f32 %0, %1, %2" : "=v"(r) : "v"(lo), "v"(hi)); return r; }
typedef float f32x2 __attribute__((ext_vector_type(2)));
typedef f32x4 Acc[2][2][4][2];

typedef int i32x4v __attribute__((ext_vector_type(4)));
typedef int i32x8v __attribute__((ext_vector_type(8)));
__device__ __forceinline__ i32x8v cat8(bf16x8 a, bf16x8 b) { const i32x4v x = __builtin_bit_cast(i32x4v, a), y = __builtin_bit_cast(i32x4v, b); return __builtin_shufflevector(x, y, 0, 1, 2, 3, 4, 5, 6, 7); }
__device__ __forceinline__ unsigned cvt4_fp8(float a, float b, float c, float d) { int w = __builtin_amdgcn_cvt_pk_fp8_f32(a, b, 0, false); w = __builtin_amdgcn_cvt_pk_fp8_f32(c, d, w, true); return (unsigned)w; }
struct NoMid { static constexpr bool ENABLED = false; __device__ __forceinline__ void operator()(Acc&, int, int, int) const {} };

struct EpiBf16 {
    static constexpr bool PERM = true, AFTER_DRAIN = false;
    bf16_t* O; int ldc; float sc;
    __device__ __forceinline__ void operator()(Acc& acc, const Unit& u, int ui, int wr, int wc, int fr, int fq) const {
        const int row0 = u.pm * BM + wr * 64 + fr, col0 = u.pn * BM + wc * 32 + 8 * fq;
#pragma unroll
        for (int ai = 0; ai < 2; ++ai)
#pragma unroll
            for (int m = 0; m < 4; ++m) { bf16_t* rowp = O + (size_t)(row0 + ai * HALF + m * 16) * ldc + col0;
#pragma unroll
                for (int bj = 0; bj < 2; ++bj) { const f32x4 v0 = acc[ai][bj][m][0] * sc, v1 = acc[ai][bj][m][1] * sc;
                    u32x4 w; w.x = cvt_pk_bf16(v0[0], v0[1]); w.y = cvt_pk_bf16(v0[2], v0[3]); w.z = cvt_pk_bf16(v1[0], v1[1]); w.w = cvt_pk_bf16(v1[2], v1[3]);
                    *(u32x4*)(rowp + bj * HALF) = w; } }
    }
};
struct MidRowScale {
    static constexpr bool ENABLED = true;
    const PG8_LAS float* scl;
    __device__ __forceinline__ void operator()(Acc& acc, int ui, int wr, int fr) const {
#pragma unroll
        for (int ai = 0; ai < 2; ++ai)
#pragma unroll
            for (int m = 0; m < 4; ++m) { const float s = scl[(ui * 256 + ai * HALF + wr * 64 + m * 16 + fr) * 2];
#pragma unroll
                for (int bj = 0; bj < 2; ++bj)
#pragma unroll
                    for (int n = 0; n < 2; ++n) acc[ai][bj][m][n] = acc[ai][bj][m][n] * s; }
    }
};
struct EpiRowScaleBf16 {
    static constexpr bool PERM = true, AFTER_DRAIN = false;
    bf16_t* O; int ldc; const PG8_LAS float* scl;
    __device__ __forceinline__ void operator()(Acc& acc, const Unit& u, int ui, int wr, int wc, int fr, int fq) const {
        const int row0 = u.pm * BM + wr * 64 + fr, col0 = u.pn * BM + wc * 32 + 8 * fq;
#pragma unroll
        for (int ai = 0; ai < 2; ++ai)
#pragma unroll
            for (int m = 0; m < 4; ++m) { bf16_t* rowp = O + (size_t)(row0 + ai * HALF + m * 16) * ldc + col0;
                const float s = scl[(ui * 256 + ai * HALF + wr * 64 + m * 16 + fr) * 2 + 1];
#pragma unroll
                for (int bj = 0; bj < 2; ++bj) { const f32x4 v0 = acc[ai][bj][m][0] * s, v1 = acc[ai][bj][m][1] * s;
                    u32x4 w; w.x = cvt_pk_bf16(v0[0], v0[1]); w.y = cvt_pk_bf16(v0[2], v0[3]); w.z = cvt_pk_bf16(v1[0], v1[1]); w.w = cvt_pk_bf16(v1[2], v1[3]);
                    *(u32x4*)(rowp + bj * HALF) = w; } }
    }
};
typedef int i32x4e __attribute__((ext_vector_type(4)));
__device__ __forceinline__ f32x4 acc_i2f(f32x4 a) { return __builtin_convertvector(__builtin_bit_cast(i32x4e, a), f32x4); }
struct EpiSwiGLUI8 {
    static constexpr bool PERM = true, AFTER_DRAIN = false;
    unsigned char* O; int ldc; const float* sh; const float* sw; int last_pn;
    static constexpr bool PREFETCH = true;
    struct State { f32x4 sg[2], su[2]; float shr[8]; };
    __device__ __forceinline__ void prefetch(State& st, const Unit& u, int wr, int wc, int fr, int fq) const {
        const float* swp = sw + u.pn * BM + wc * 32 + 8 * fq; const float* shp = sh + u.pm * BM + wr * 64 + fr;
        st.sg[0] = *(const f32x4*)swp; st.sg[1] = *(const f32x4*)(swp + 4); st.su[0] = *(const f32x4*)(swp + HALF); st.su[1] = *(const f32x4*)(swp + HALF + 4);
#pragma unroll
        for (int i = 0; i < 8; ++i) st.shr[i] = shp[(i >> 2) * HALF + (i & 3) * 16];
    }
    __device__ __forceinline__ void operator()(Acc& acc, const Unit& u, int ui, int wr, int wc, int fr, int fq, const State& st) const {
        const int row0 = u.pm * BM + wr * 64 + fr, col0 = u.pn * HALF + wc * 32 + 8 * fq;
        const f32x4 sg[2] = {st.sg[0], st.sg[1]}, su[2] = {st.su[0] * 4.0f, st.su[1] * 4.0f};
#pragma unroll
        for (int ai = 0; ai < 2; ++ai)
#pragma unroll
            for (int m = 0; m < 4; ++m) { const int row = row0 + ai * HALF + m * 16; unsigned char* rowp = O + (size_t)row * ldc + col0; const float shr = st.shr[ai * 4 + m];
                typedef unsigned u32x2v __attribute__((ext_vector_type(2)));
                u32x2v w;
#pragma unroll
                for (int n = 0; n < 2; ++n) { const f32x4 g = acc_i2f(acc[ai][0][m][n]) * (sg[n] * shr), uu = acc_i2f(acc[ai][1][m][n]) * (su[n] * shr);
                    f32x4 e = g * -1.4426950408889634f; e = (f32x4){__builtin_amdgcn_exp2f(e[0]), __builtin_amdgcn_exp2f(e[1]), __builtin_amdgcn_exp2f(e[2]), __builtin_amdgcn_exp2f(e[3])} + 1.0f;
                    const f32x4 r = (f32x4){__builtin_amdgcn_rcpf(e[0]), __builtin_amdgcn_rcpf(e[1]), __builtin_amdgcn_rcpf(e[2]), __builtin_amdgcn_rcpf(e[3])}, v = (g * uu) * r;
                    const unsigned q8 = cvt4_fp8(__builtin_amdgcn_fmed3f(v[0], -448.f, 448.f), __builtin_amdgcn_fmed3f(v[1], -448.f, 448.f), __builtin_amdgcn_fmed3f(v[2], -448.f, 448.f), __builtin_amdgcn_fmed3f(v[3], -448.f, 448.f));
                    if (n == 0) w.x = q8; else w.y = q8; }
                *(u32x2v*)rowp = w; if (u.pn == last_pn) *(u32x2v*)(rowp + HALF) = (u32x2v){0u, 0u}; }
    }
};
struct EpiKVXG {
    static constexpr bool PERM = true, AFTER_DRAIN = false;
    unsigned char* base5; const float* sh; const float* sw; const float* rope; float* kmean;
    __device__ __forceinline__ void operator()(Acc& acc, const Unit& u, int ui, int wr, int wc, int fr, int fq) const {
        const int region = u.pn >> 2, sub = u.pn & 3;
        const float qsc = region == 0 ? 0.12751743074602467f : 1.0f;
        { const float* swp = sw + u.pn * BM + wc * 32 + 8 * fq;
#pragma unroll
          for (int bj = 0; bj < 2; ++bj) { const f32x4 s0 = *(const f32x4*)(swp + bj * HALF), s1 = *(const f32x4*)(swp + bj * HALF + 4);
#pragma unroll
              for (int ai = 0; ai < 2; ++ai)
#pragma unroll
                  for (int m = 0; m < 4; ++m) { const float shr = sh[u.pm * BM + wr * 64 + fr + ai * HALF + m * 16] * qsc;
                      acc[ai][bj][m][0] = acc_i2f(acc[ai][bj][m][0]) * (s0 * shr); acc[ai][bj][m][1] = acc_i2f(acc[ai][bj][m][1]) * (s1 * shr); } } }
        bf16_t* dst = (bf16_t*)(base5 + (size_t)region * (32u << 20));
        const int b = u.pm >> 4, blk = u.pm & 15, s0 = blk * 256 + wr * 64 + fr;
        if (region <= 1) {
            bf16_t* base = dst + ((size_t)(b * 8 + sub * 2) * 4096 + s0) * 128 + wc * 32 + 8 * fq;
            f32x4 ks[2][2];
#pragma unroll
            for (int bj = 0; bj < 2; ++bj)
#pragma unroll
                for (int n = 0; n < 2; ++n) ks[bj][n] = (f32x4){0.f, 0.f, 0.f, 0.f};
            if (wc == 0) {
                const float sgn = fq < 2 ? -1.0f : 1.0f;
                const float* rp = rope + ((size_t)s0 * 16 + 8 * (fq & 1)) * 2;
#pragma unroll
                for (int ai = 0; ai < 2; ++ai)
#pragma unroll
                    for (int m = 0; m < 4; ++m) { const f32x4* cs = (const f32x4*)(rp + (size_t)(ai * HALF + m * 16) * 32);
#pragma unroll
                        for (int bj = 0; bj < 2; ++bj) { f32x4 o[2];
#pragma unroll
                            for (int n = 0; n < 2; ++n) { const f32x4 ca = cs[2 * n], cb = cs[2 * n + 1]; const f32x4 v = acc[ai][bj][m][n];
                                const f32x4 p = (f32x4){__shfl_xor(v[0], 32), __shfl_xor(v[1], 32), __shfl_xor(v[2], 32), __shfl_xor(v[3], 32)};
                                o[n] = (f32x4){fmaf(sgn * p[0], ca[1], v[0] * ca[0]), fmaf(sgn * p[1], ca[3], v[1] * ca[2]), fmaf(sgn * p[2], cb[1], v[2] * cb[0]), fmaf(sgn * p[3], cb[3], v[3] * cb[2])}; }
                            u32x4 w; w.x = cvt_pk_bf16(o[0][0], o[0][1]); w.y = cvt_pk_bf16(o[0][2], o[0][3]); w.z = cvt_pk_bf16(o[1][0], o[1][1]); w.w = cvt_pk_bf16(o[1][2], o[1][3]);
                            *(u32x4*)(base + (size_t)bj * 4096 * 128 + (size_t)(ai * HALF + m * 16) * 128) = w;
                            ks[bj][0] += o[0]; ks[bj][1] += o[1]; } }
            } else {
#pragma unroll
                for (int ai = 0; ai < 2; ++ai)
#pragma unroll
                    for (int m = 0; m < 4; ++m)
#pragma unroll
                        for (int bj = 0; bj < 2; ++bj) { const f32x4 v0 = acc[ai][bj][m][0], v1 = acc[ai][bj][m][1];
                            u32x4 w; w.x = cvt_pk_bf16(v0[0], v0[1]); w.y = cvt_pk_bf16(v0[2], v0[3]); w.z = cvt_pk_bf16(v1[0], v1[1]); w.w = cvt_pk_bf16(v1[2], v1[3]);
                            *(u32x4*)(base + (size_t)bj * 4096 * 128 + (size_t)(ai * HALF + m * 16) * 128) = w;
                            ks[bj][0] += v0; ks[bj][1] += v1; }
            }
            if (region == 1)
#pragma unroll
            for (int bj = 0; bj < 2; ++bj) { float* kd = kmean + ((size_t)(b * 8 + sub * 2 + bj) * 16 + blk) * 128 + wc * 32 + 8 * fq;
#pragma unroll
                for (int n = 0; n < 2; ++n)
#pragma unroll
                    for (int j = 0; j < 4; ++j) { float t = ks[bj][n][j]; t += __shfl_xor(t, 1); t += __shfl_xor(t, 2); t += __shfl_xor(t, 4); t += __shfl_xor(t, 8);
                        if (fr == 0) unsafeAtomicAdd(kd + 4 * n + j, t); } }
            return;
        }
        bf16_t* base = region == 2 ? dst + ((size_t)(b * 8 + sub * 2) * 4096 + s0) * 128 + wc * 32 + 8 * fq : dst + ((size_t)u.pm * BM + wr * 64 + fr) * 1024 + sub * BM + wc * 32 + 8 * fq;
        const size_t rstep = region == 2 ? 128 : 1024, bstep = region == 2 ? (size_t)4096 * 128 : 128;
#pragma unroll
        for (int ai = 0; ai < 2; ++ai)
#pragma unroll
            for (int m = 0; m < 4; ++m)
#pragma unroll
                for (int bj = 0; bj < 2; ++bj) { f32x4 v0 = acc[ai][bj][m][0], v1 = acc[ai][bj][m][1];
                    if (region == 4) {
#pragma unroll
                        for (int e = 0; e < 4; ++e) { const float g0 = v0[e], g1 = v1[e];
                            v0[e] = g0 * __builtin_amdgcn_rcpf(1.0f + __builtin_amdgcn_exp2f(-2.3022082f * (g0 + 0.044715f * g0 * g0 * g0)));
                            v1[e] = g1 * __builtin_amdgcn_rcpf(1.0f + __builtin_amdgcn_exp2f(-2.3022082f * (g1 + 0.044715f * g1 * g1 * g1))); } }
                    u32x4 w; w.x = cvt_pk_bf16(v0[0], v0[1]); w.y = cvt_pk_bf16(v0[2], v0[3]); w.z = cvt_pk_bf16(v1[0], v1[1]); w.w = cvt_pk_bf16(v1[2], v1[3]);
                    *(u32x4*)(base + (size_t)bj * bstep + (size_t)(ai * HALF + m * 16) * rstep) = w; }
    }
};

template <class E, class = void> struct epi_prefetch { static constexpr bool value = false; };
template <class E> struct epi_prefetch<E, decltype((void)E::PREFETCH)> { static constexpr bool value = E::PREFETCH; };
template <class E, bool P> struct epi_state { };
template <class E> struct epi_state<E, true> { typename E::State s; };
template <class Epi, class Sched, class Mid, bool ALIGN_EPI = false, bool SP2 = false, int MODE = 0  >
__device__ __forceinline__ void gemm_phase(PG8_LAS unsigned char* lds, const Gemm g, const Sched& S, const Epi& E, const Mid& MH) {
    const int tid = threadIdx.x, wid = __builtin_amdgcn_readfirstlane(tid >> 6), lane = tid & 63, wr = wid >> 2, wc = wid & 3, fr = lane & 15, fq = lane >> 4;
    const int K = g.K, nt = K / BK;
    unsigned voffA[2], voffB[2];
#pragma unroll
    for (int i = 0; i < 2; ++i) { int R, C; stage_rc(tid * 16 + i * 8192, R, C); const int Rb = Epi::PERM ? ((R & ~31) + perm32(R & 31)) : R;
        voffA[i] = (unsigned)(R * K + C) * 2u; voffB[i] = (unsigned)(Rb * K + C) * 2u; }
    const size_t kstep = (size_t)(BK * 2);
    const size_t hstep = (size_t)HALF * K * 2;
    const size_t tstep = 2 * hstep;
    const unsigned ldsw = (unsigned)wid * 1024u;
    const int aoff = lds_byte(wr * 64 + fr, fq * 8), boff = lds_byte(wc * 32 + fr, fq * 8);
#define PG8_SA(b, h) (((b) * 2 + (h)) * HTB)
#define PG8_SB(b, h) ((4 + (b) * 2 + (h)) * HTB)
#define PG8_STAGE(bufoff, gbase, voff) do { _Pragma("unroll") for (int _i = 0; _i < 2; ++_i) \
        __builtin_amdgcn_global_load_lds((const unsigned*)((const char*)(gbase) + (voff)[_i]), (PG8_LAS unsigned*)(lds + (bufoff) + ldsw + _i * 8192), 16, 0, 0); } while (0)
#define PG8_LDA(dst, b, h) do { _Pragma("unroll") for (int m = 0; m < 4; ++m) _Pragma("unroll") for (int k = 0; k < 2; ++k) dst[m][k] = *(const PG8_LAS bf16x8*)(lds + PG8_SA(b, h) + aoff + m * 2048 + k * 1024); } while (0)
#define PG8_LDB(dst, b, h) do { _Pragma("unroll") for (int n = 0; n < 2; ++n) _Pragma("unroll") for (int k = 0; k < 2; ++k) dst[n][k] = *(const PG8_LAS bf16x8*)(lds + PG8_SB(b, h) + boff + n * 2048 + k * 1024); } while (0)
#define PG8_MMA(ai, bj, At, Bt) do { __builtin_amdgcn_s_setprio(1); if constexpr (MODE == 1) { _Pragma("unroll") for (int m = 0; m < 4; ++m) _Pragma("unroll") for (int n = 0; n < 2; ++n) \
        { const i32x8v a8_ = cat8(Bt[n][0], Bt[n][1]), b8_ = cat8(At[m][0], At[m][1]); asm volatile("v_mfma_f32_16x16x128_f8f6f4 %0, %1, %2, %0" : "+v"(acc[ai][bj][m][n]) : "v"(a8_), "v"(b8_)); } } \
        else if constexpr (MODE == 2) { _Pragma("unroll") for (int m = 0; m < 4; ++m) _Pragma("unroll") for (int n = 0; n < 2; ++n) _Pragma("unroll") for (int k = 0; k < 2; ++k) \
        acc[ai][bj][m][n] = __builtin_bit_cast(f32x4, __builtin_amdgcn_mfma_i32_16x16x64_i8(__builtin_bit_cast(i32x4v, Bt[n][k]), __builtin_bit_cast(i32x4v, At[m][k]), __builtin_bit_cast(i32x4v, acc[ai][bj][m][n]), 0, 0, 0)); } \
        else { _Pragma("unroll") for (int m = 0; m < 4; ++m) _Pragma("unroll") for (int n = 0; n < 2; ++n) _Pragma("unroll") for (int k = 0; k < 2; ++k) \
        acc[ai][bj][m][n] = __builtin_amdgcn_mfma_f32_16x16x32_bf16(Bt[n][k], At[m][k], acc[ai][bj][m][n], 0, 0, 0); } __builtin_amdgcn_s_setprio(0); } while (0)
#define PG8_WAIT_V(n) asm volatile("s_waitcnt vmcnt(" #n ")" ::: "memory")
#define PG8_WAIT_L(n) asm volatile("s_waitcnt lgkmcnt(" #n ")" ::: "memory")
#define PG8_BAR __builtin_amdgcn_s_barrier()
#define PG8_SCHED __builtin_amdgcn_sched_barrier(0)
    Unit cur, nxt; int ui = 0;
    if (!S.next(0, cur)) return;
    epi_state<Epi, epi_prefetch<Epi>::value> est;
    Acc acc;
#pragma unroll
    for (int a = 0; a < 2; ++a)
#pragma unroll
        for (int b = 0; b < 2; ++b)
#pragma unroll
            for (int m = 0; m < 4; ++m)
#pragma unroll
                for (int n = 0; n < 2; ++n) acc[a][b][m][n] = (f32x4){0.f, 0.f, 0.f, 0.f};
    bf16x8 At[4][2], B0[2][2], B1[2][2];
    const char* cA = (const char*)g.A + (size_t)cur.pm * tstep; const char* cB = (const char*)g.Bt + (size_t)cur.pn * tstep;
    S.a_ready(cur);
    if constexpr (SP2) {
        PG8_STAGE(PG8_SB(0, 0), cB, voffB); PG8_STAGE(PG8_SB(0, 1), cB + hstep, voffB); PG8_STAGE(PG8_SA(0, 0), cA, voffA); PG8_STAGE(PG8_SA(0, 1), cA + hstep, voffA);
        if (wr == 1) PG8_BAR;
        PG8_WAIT_V(2); PG8_BAR;
        PG8_STAGE(PG8_SB(1, 0), cB + kstep, voffB); PG8_STAGE(PG8_SA(1, 0), cA + kstep, voffA); PG8_STAGE(PG8_SB(1, 1), cB + hstep + kstep, voffB);
        PG8_WAIT_V(6); PG8_BAR;
    } else {
        PG8_STAGE(PG8_SB(0, 0), cB, voffB); PG8_STAGE(PG8_SA(0, 0), cA, voffA); PG8_STAGE(PG8_SB(0, 1), cB + hstep, voffB); PG8_STAGE(PG8_SA(0, 1), cA + hstep, voffA);
        if (wr == 1) PG8_BAR;
        PG8_WAIT_V(4); PG8_BAR;
        PG8_STAGE(PG8_SB(1, 0), cB + kstep, voffB); PG8_STAGE(PG8_SA(1, 0), cA + kstep, voffA); PG8_STAGE(PG8_SB(1, 1), cB + hstep + kstep, voffB);
        PG8_WAIT_V(6); PG8_BAR;
    }
    for (;;) {
        const bool has_next = S.next(ui + 1, nxt);
        const char* nA = has_next ? (const char*)g.A + (size_t)nxt.pm * tstep : cA; const char* nB = has_next ? (const char*)g.Bt + (size_t)nxt.pn * tstep : cB;
        for (int t = 0; t < nt; t += 2) {
            const bool last = (t == nt - 2);
            const char* a1 = cA + (size_t)(t + 1) * kstep;
            const char* a2 = last ? nA : cA + (size_t)(t + 2) * kstep; const char* b2 = last ? nB : cB + (size_t)(t + 2) * kstep;
            const char* a3 = a2 + kstep; const char* b3 = b2 + kstep;
            if (last && has_next) S.a_ready(nxt);
            if constexpr (Mid::ENABLED) { if (t == (nt >> 1)) { if constexpr (MODE == 1) asm volatile("s_nop 15\n\ts_nop 15" ::: "memory"); MH(acc, ui, wr, fr); } }
            if constexpr (SP2) {
            PG8_LDB(B0, 0, 0); PG8_LDB(B1, 0, 1); PG8_SCHED; PG8_LDA(At, 0, 0); PG8_STAGE(PG8_SA(1, 1), a1 + hstep, voffA);
            PG8_WAIT_V(8); PG8_WAIT_L(0); PG8_BAR; PG8_MMA(0, 0, At, B0); PG8_MMA(0, 1, At, B1); PG8_BAR; PG8_SCHED;
            PG8_LDA(At, 0, 1); PG8_STAGE(PG8_SB(0, 0), b2, voffB); PG8_STAGE(PG8_SB(0, 1), b2 + hstep, voffB); PG8_STAGE(PG8_SA(0, 0), a2, voffA);
            PG8_WAIT_V(8); PG8_WAIT_L(0); PG8_BAR; PG8_MMA(1, 0, At, B0); PG8_MMA(1, 1, At, B1); PG8_BAR; PG8_SCHED;
            PG8_LDB(B0, 1, 0); PG8_LDB(B1, 1, 1); PG8_SCHED; PG8_LDA(At, 1, 0); PG8_STAGE(PG8_SA(0, 1), a2 + hstep, voffA);
            PG8_WAIT_V(8); PG8_WAIT_L(0); PG8_BAR; PG8_MMA(0, 0, At, B0); PG8_MMA(0, 1, At, B1); PG8_BAR; PG8_SCHED;
            PG8_LDA(At, 1, 1); PG8_STAGE(PG8_SB(1, 0), b3, voffB); PG8_STAGE(PG8_SB(1, 1), b3 + hstep, voffB); PG8_STAGE(PG8_SA(1, 0), a3, voffA);
            PG8_WAIT_V(8); PG8_WAIT_L(0); PG8_BAR; PG8_MMA(1, 0, At, B0); PG8_MMA(1, 1, At, B1); PG8_BAR; PG8_SCHED;
            } else {
            PG8_LDB(B0, 0, 0); PG8_SCHED; PG8_LDA(At, 0, 0); PG8_STAGE(PG8_SA(1, 1), a1 + hstep, voffA);
            PG8_WAIT_L(8); PG8_BAR; PG8_WAIT_L(0); PG8_MMA(0, 0, At, B0); PG8_BAR; PG8_SCHED;
            PG8_LDB(B1, 0, 1); PG8_STAGE(PG8_SB(0, 0), b2, voffB);
            PG8_BAR; PG8_WAIT_L(0); PG8_MMA(0, 1, At, B1); PG8_BAR;
            PG8_LDA(At, 0, 1); PG8_STAGE(PG8_SA(0, 0), a2, voffA);
            PG8_BAR; PG8_WAIT_L(0); PG8_MMA(1, 0, At, B0); PG8_BAR; PG8_SCHED;
            PG8_STAGE(PG8_SB(0, 1), b2 + hstep, voffB);
            PG8_WAIT_V(6); PG8_BAR; PG8_MMA(1, 1, At, B1); PG8_BAR;
            PG8_LDB(B0, 1, 0); PG8_SCHED; PG8_LDA(At, 1, 0); PG8_STAGE(PG8_SA(0, 1), a2 + hstep, voffA);
            PG8_WAIT_L(8); PG8_BAR; PG8_WAIT_L(0); PG8_MMA(0, 0, At, B0); PG8_BAR; PG8_SCHED;
            PG8_LDB(B1, 1, 1); PG8_STAGE(PG8_SB(1, 0), b3, voffB);
            PG8_BAR; PG8_WAIT_L(0); PG8_MMA(0, 1, At, B1); PG8_BAR;
            PG8_LDA(At, 1, 1); PG8_STAGE(PG8_SA(1, 0), a3, voffA);
            PG8_BAR; PG8_WAIT_L(0); PG8_MMA(1, 0, At, B0); PG8_BAR; PG8_SCHED;
            PG8_STAGE(PG8_SB(1, 1), b3 + hstep, voffB);
            PG8_WAIT_V(6); PG8_BAR; PG8_MMA(1, 1, At, B1); PG8_BAR;
            }
        }
        if constexpr (epi_prefetch<Epi>::value) E.prefetch(est.s, cur, wr, wc, fr, fq);
        if constexpr (MODE == 1) asm volatile("s_nop 15\n\ts_nop 15" ::: "memory");
        if constexpr (ALIGN_EPI) { if (wr == 0) PG8_BAR; }
        if constexpr (epi_prefetch<Epi>::value) E(acc, cur, ui, wr, wc, fr, fq, est.s); else E(acc, cur, ui, wr, wc, fr, fq);
        if (!has_next) break;
#pragma unroll
        for (int a = 0; a < 2; ++a)
#pragma unroll
            for (int b = 0; b < 2; ++b)
#pragma unroll
                for (int m = 0; m < 4; ++m)
#pragma unroll
                    for (int n = 0; n < 2; ++n) acc[a][b][m][n] = (f32x4){0.f, 0.f, 0.f, 0.f};
        cur = nxt; cA = nA; cB = nB; ++ui;
        if constexpr (ALIGN_EPI) { if (wr == 1) PG8_BAR; }
    }
    PG8_WAIT_V(0);
    if constexpr (!ALIGN_EPI) { if (wr == 0) PG8_BAR; }
    PG8_BAR;
#undef PG8_SA
#undef PG8_SB
#undef PG8_STAGE
#undef PG8_LDA
#undef PG8_LDB
#undef PG8_MMA
#undef PG8_WAIT_V
#undef PG8_WAIT_L
#undef PG8_BAR
#undef PG8_SCHED
}
}

namespace moba {
constexpr int D = 128, SKV = 4096, OPITCH = 2048;
constexpr float SCALE = 0.08838834764831845f;
constexpr float THR = 8.f;
constexpr int NW = 8, QBLK = 32, KVBLK = 64, QB = NW * QBLK;
constexpr int SHM_V = KVBLK * D * 2, SHM_K = KVBLK * 272;
constexpr int NVS = 3;
constexpr int LDS_WS = NVS * SHM_V + 2 * SHM_K, LDS_KM = LDS_WS + NW * 64 * 4, LDS_BYTES = LDS_KM + 16 * 128 * 4;
typedef unsigned short bf16;
typedef short bf16x8 __attribute__((ext_vector_type(8)));
typedef short s16x4 __attribute__((ext_vector_type(4)));
typedef float f32x16 __attribute__((ext_vector_type(16)));
typedef float f32x4 __attribute__((ext_vector_type(4)));
typedef float f32x2 __attribute__((ext_vector_type(2)));
typedef unsigned u32x4 __attribute__((ext_vector_type(4)));

constexpr int KPITCH = 272;
#define KSWZ(row, colB) ((row) * KPITCH + (colB))
#define SBAR() __builtin_amdgcn_sched_barrier(0)
__device__ __forceinline__ int v_st(int k, int c) { const int kk = k;     return ((kk >> 3) * 4 + (c >> 5)) * 512 + ((kk & 7) * 32 + (c & 31)) * 2; }
__device__ __forceinline__ int v_rd_base(int lane) { return ((lane & 3) << 3) | (((lane >> 2) & 3) << 6) | (((lane >> 4) & 1) << 5) | (((lane >> 5) & 1) << 8); }
constexpr int v_rd_off(int d0, int ks, int half) { return d0 * 512 + ks * 4096 + half * 2048; }
__device__ __forceinline__ int crow(int r, int hi) { return (r & 3) + 8 * (r >> 2) + 4 * hi; }
__device__ __forceinline__ unsigned cvtpk(float lo, float hi) { unsigned r; asm volatile("v_cvt_pk_bf16_f32 %0, %1, %2" : "=v"(r) : "v"(lo), "v"(hi)); return r; }
__device__ __forceinline__ bf16x8 load8(const bf16* p) { return *reinterpret_cast<const bf16x8*>(p); }
__device__ __forceinline__ bf16x8 load8nt(const bf16* p) { return __builtin_nontemporal_load(reinterpret_cast<const bf16x8*>(p)); }
__device__ __forceinline__ void mask_tile(f32x16& p0, f32x16& p1, int dq) {
    const float NEG = -__builtin_inff();
#define MT1(P, r, cc) do { float t_ = P[r]; asm volatile("v_cmp_gt_i32_e32 vcc, %2, %1\n\tv_cndmask_b32_e32 %0, %0, %3, vcc" : "+v"(t_) : "v"(dq), "n"(cc), "v"(NEG) : "vcc"); P[r] = t_; } while (0)
#define MT2(r) do { MT1(p0, r, ((r) & 3) + 8 * ((r) >> 2)); MT1(p1, r, ((r) & 3) + 8 * ((r) >> 2) + 32); } while (0)
    MT2(0); MT2(1); MT2(2); MT2(3); MT2(4); MT2(5); MT2(6); MT2(7); MT2(8); MT2(9); MT2(10); MT2(11); MT2(12); MT2(13); MT2(14); MT2(15);
#undef MT2
#undef MT1
}
constexpr float THR2 = THR * 1.4426950408889634f;
__device__ __forceinline__ void partialSM(f32x16& p0, f32x16& p1, float& negm, float& l_reg, float& alpha) {
    float pmax = fmaxf(p0[0], p0[1]); for (int r = 2; r < 16; ++r) pmax = fmaxf(pmax, p0[r]); for (int r = 0; r < 16; ++r) pmax = fmaxf(pmax, p1[r]);
    { auto rr = __builtin_amdgcn_permlane32_swap(__float_as_uint(pmax), __float_as_uint(pmax), false, false);
      pmax = fmaxf(__uint_as_float(rr[0]), __uint_as_float(rr[1])); }
    const float NINF = -__builtin_inff();
    const bool sb = l_reg > 0.f;
    alpha = 1.f;
    if (__builtin_expect(!__all(pmax <= (sb ? THR2 : NINF)), 0)) {
        const float mc = pmax - negm;
        const float mold = sb ? -negm : NINF;
        const float mnew = fmaxf(mold, mc);
        const bool seen = mnew > NINF;
        const float delta = seen ? mnew + negm : 0.f;
        if (sb) alpha = __builtin_amdgcn_exp2f(mold - mnew);
        if (seen) negm = -mnew;
        l_reg *= alpha;
        for (int r = 0; r < 16; ++r) p0[r] -= delta; for (int r = 0; r < 16; ++r) p1[r] -= delta;
    }
    for (int r = 0; r < 16; ++r) p0[r] = __builtin_amdgcn_exp2f(p0[r]);
}
__device__ __forceinline__ void finishSM(f32x16& p0, f32x16& p1, float& l_reg, bf16x8& pa0, bf16x8& pa1, bf16x8& pa2, bf16x8& pa3) {
    for (int r = 0; r < 16; ++r) p1[r] = __builtin_amdgcn_exp2f(p1[r]);
    f32x2 s2 = {p0[0], p0[1]};
    for (int i = 1; i < 8; ++i) s2 += (f32x2){p0[2 * i], p0[2 * i + 1]};
    for (int i = 0; i < 8; ++i) s2 += (f32x2){p1[2 * i], p1[2 * i + 1]};
    float ps = s2[0] + s2[1];
    { auto rr = __builtin_amdgcn_permlane32_swap(__float_as_uint(ps), __float_as_uint(ps), false, false);
      ps = __uint_as_float(rr[0]) + __uint_as_float(rr[1]); }
    l_reg += ps;
#define PK4(P, B_, OUT) do { u32x4 w = {cvtpk(P[B_+0], P[B_+1]), cvtpk(P[B_+2], P[B_+3]), cvtpk(P[B_+4], P[B_+5]), cvtpk(P[B_+6], P[B_+7])}; OUT = *reinterpret_cast<bf16x8*>(&w); } while (0)
    PK4(p0, 0, pa0); PK4(p0, 8, pa1); PK4(p1, 0, pa2); PK4(p1, 8, pa3);
#undef PK4
}
template <int KB>
__device__ __forceinline__ void qkt(f32x16& p0, f32x16& p1, const char* K_lds, int r32, int hi, const bf16x8* qr, float init) {
    for (int r = 0; r < 16; ++r) { p0[r] = init; p1[r] = init; }
    const char* kb = K_lds + KB * SHM_K + KSWZ(r32, hi * 16);
#pragma unroll
    for (int d0 = 0; d0 < 8; ++d0) { const char* a = kb + d0 * 32;
        bf16x8 b0 = *reinterpret_cast<const bf16x8*>(a);
        bf16x8 b1 = *reinterpret_cast<const bf16x8*>(a + 32 * KPITCH);
        p0 = __builtin_amdgcn_mfma_f32_32x32x16_bf16(b0, qr[d0], p0, 0, 0, 0);
        p1 = __builtin_amdgcn_mfma_f32_32x32x16_bf16(b1, qr[d0], p1, 0, 0, 0); }
}
template <int VB>
__device__ __forceinline__ void pv_tile(f32x16* o, int vb0, bf16x8 pa0, bf16x8 pa1, bf16x8 pa2, bf16x8 pa3) {
#define TRRD(dst, off) asm volatile("ds_read_b64_tr_b16 %0, %1 offset:%2" : "=&v"(dst) : "v"(vb0), "i"(off) : "memory")
#define PV_D0(d0) do { s16x4 l0, l1, l2, l3, h0, h1, h2, h3; constexpr int b_ = VB * SHM_V + v_rd_off(d0, 0, 0);     \
        TRRD(l0, b_); TRRD(h0, b_ + 2048); TRRD(l1, b_ + 4096); TRRD(h1, b_ + 6144); TRRD(l2, b_ + 8192); TRRD(h2, b_ + 10240); TRRD(l3, b_ + 12288); TRRD(h3, b_ + 14336); \
        asm volatile("s_waitcnt lgkmcnt(0)" ::: "memory"); SBAR();                 \
        o[d0] = __builtin_amdgcn_mfma_f32_32x32x16_bf16(pa0, (bf16x8){l0[0], l0[1], l0[2], l0[3], h0[0], h0[1], h0[2], h0[3]}, o[d0], 0, 0, 0);   \
        o[d0] = __builtin_amdgcn_mfma_f32_32x32x16_bf16(pa1, (bf16x8){l1[0], l1[1], l1[2], l1[3], h1[0], h1[1], h1[2], h1[3]}, o[d0], 0, 0, 0);   \
        o[d0] = __builtin_amdgcn_mfma_f32_32x32x16_bf16(pa2, (bf16x8){l2[0], l2[1], l2[2], l2[3], h2[0], h2[1], h2[2], h2[3]}, o[d0], 0, 0, 0);   \
        o[d0] = __builtin_amdgcn_mfma_f32_32x32x16_bf16(pa3, (bf16x8){l3[0], l3[1], l3[2], l3[3], h3[0], h3[1], h3[2], h3[3]}, o[d0], 0, 0, 0); } while (0)
    PV_D0(0); PV_D0(1); PV_D0(2); PV_D0(3);
#undef PV_D0
#undef TRRD
}
struct BlockRef { const bf16* Q; const bf16* K; const bf16* V; unsigned char* O; float* SS; const float* KM; int P0; };
struct Seam { bf16x8 qr[8]; bf16x8 st_v0, st_v1, st_k0, st_k1; };
#define ROW(p, k0, rr) ((p) + (size_t)((k0) + (rr)) * D + sc)
#define VMW() asm volatile("s_waitcnt vmcnt(0)" ::: "memory")
#define VMWN(n) asm volatile("s_waitcnt vmcnt(%0)" :: "i"(n) : "memory")
#define SLOAD_H(Kp, Vp, k0) do { S.st_v0 = load8(ROW(Vp, k0, sr)); S.st_v1 = load8(ROW(Vp, k0, 32 + sr));              \
                         S.st_k0 = load8(ROW(Kp, k0, sr)); S.st_k1 = load8(ROW(Kp, k0, 32 + sr)); } while (0)
#define SWRITE_HK(bf) do { *(bf16x8*)(K_lds + (bf) * SHM_K + kws) = S.st_k0; *(bf16x8*)(K_lds + (bf) * SHM_K + kws + 32 * KPITCH) = S.st_k1; } while (0)
#define SWRITE_HV(bf) do { *(bf16x8*)(V_lds + (bf) * SHM_V + vst0) = S.st_v0; *(bf16x8*)(V_lds + (bf) * SHM_V + vst1) = S.st_v1; } while (0)
#define SWRITE_H(bf) do { SWRITE_HV(bf); SWRITE_HK(bf); } while (0)
__device__ __forceinline__ void moba_prime(const BlockRef& cur, char* lds, Seam& S) {
    int tid_o = threadIdx.x; asm volatile("" : "+v"(tid_o));
    const int tid = tid_o, wid = __builtin_amdgcn_readfirstlane(tid >> 6), lane = tid & 63, r32 = lane & 31, hi = lane >> 5;
    const int sr = tid >> 4, sc = (tid & 15) * 8, kws = KSWZ(sr, sc * 2); char* K_lds = lds + NVS * SHM_V;
    for (int d0 = 0; d0 < 8; ++d0) S.qr[d0] = load8nt(cur.Q + (size_t)(wid * QBLK + r32) * D + d0 * 16 + hi * 8);
    SLOAD_H(cur.K, cur.V, 0); VMW(); SWRITE_HK(0);
    __syncthreads();
}
__device__ __forceinline__ unsigned moba_select(const BlockRef& cur, char* lds, const Seam& S) {
    int tid_o = threadIdx.x; asm volatile("" : "+v"(tid_o));
    const int tid = tid_o, lane = tid & 63, hi = lane >> 5;
    const int own = cur.P0 >> 8;
    float* km = (float*)(lds + LDS_KM);
    __syncthreads();
    *(f32x4*)(km + tid * 4) = *(const f32x4*)(cur.KM + tid * 4);
    __syncthreads();
    float v1 = -__builtin_inff(), v2 = v1, v3 = v1; int i1 = 31, i2 = 31, i3 = 31;
    typedef __attribute__((address_space(3))) const f32x4 lds_f4;
    lds_f4* kr0 = (lds_f4*)(km + hi * 8);
    for (int j = 0; j < own; ++j) {
        lds_f4* kr = kr0 + j * 32; float a0 = 0.f, a1 = 0.f, a2 = 0.f, a3 = 0.f;
#pragma unroll
        for (int d0 = 0; d0 < 8; ++d0) { const f32x4 k0 = kr[d0 * 4], k1 = kr[d0 * 4 + 1]; const bf16x8 q = S.qr[d0];
            a0 = fmaf(__uint_as_float((unsigned)(unsigned short)q[0] << 16), k0[0], a0); a1 = fmaf(__uint_as_float((unsigned)(unsigned short)q[1] << 16), k0[1], a1);
            a2 = fmaf(__uint_as_float((unsigned)(unsigned short)q[2] << 16), k0[2], a2); a3 = fmaf(__uint_as_float((unsigned)(unsigned short)q[3] << 16), k0[3], a3);
            a0 = fmaf(__uint_as_float((unsigned)(unsigned short)q[4] << 16), k1[0], a0); a1 = fmaf(__uint_as_float((unsigned)(unsigned short)q[5] << 16), k1[1], a1);
            a2 = fmaf(__uint_as_float((unsigned)(unsigned short)q[6] << 16), k1[2], a2); a3 = fmaf(__uint_as_float((unsigned)(unsigned short)q[7] << 16), k1[3], a3); }
        const float a = (a0 + a1) + (a2 + a3);
        const float t = a + __shfl_xor(a, 32);
        if (t > v1) { v3 = v2; i3 = i2; v2 = v1; i2 = i1; v1 = t; i1 = j; }
        else if (t > v2) { v3 = v2; i3 = i2; v2 = t; i2 = j; }
        else if (t > v3) { v3 = t; i3 = j; }
    }
    return ((1u << i1) | (1u << i2) | (1u << i3)) & 0xffffu;
}
__device__ __forceinline__ void moba_block(const BlockRef& cur, const BlockRef& nxt, unsigned sel, char* lds, Seam& S) {
    int tid_o = threadIdx.x; asm volatile("" : "+v"(tid_o));
    const int tid = tid_o, wid = __builtin_amdgcn_readfirstlane(tid >> 6), lane = tid & 63, r32 = lane & 31, hi = lane >> 5;
    const int NT = cur.P0 / KVBLK + 4;
    const int qlo = cur.P0 + wid * QBLK, qm = qlo + r32 - 4 * hi;
    char* V_lds = lds; char* K_lds = lds + NVS * SHM_V;
    float* ws = (float*)(lds + LDS_WS) + wid * 64; float* li_l = ws, * al_l = ws + 32;
    float l_reg = 0, negm = 0.f; f32x16 o[4] = {};
    const int sr = tid >> 4, sc = (tid & 15) * 8, vst0 = v_st(sr, sc), vst1 = v_st(32 + sr, sc), kws = KSWZ(sr, sc * 2);
    const int vb0 = (int)(uintptr_t)V_lds + v_rd_base(lane);
    const bf16* Kh = cur.K; const bf16* Vh = cur.V;
#define RESC(a) do { if (__any((a) < 1.f)) { if (hi == 0) al_l[r32] = (a); asm volatile("s_waitcnt lgkmcnt(0)" ::: "memory");              \
                     for (int d_ = 0; d_ < 4; ++d_) for (int r = 0; r < 16; ++r) o[d_][r] *= al_l[crow(r, hi)]; } } while (0)
#define KBASE(t) ((t) * KVBLK)
#define TINIT(t) ((KBASE(t) < cur.P0 && ((sel >> (KBASE(t) >> 8)) & 1u) == 0u) ? -__builtin_inff() : negm)
#define MASKT(P0_, P1_, t) do { const int kb_ = KBASE(t); if (kb_ >= cur.P0 && kb_ + KVBLK - 1 > qlo) mask_tile(P0_, P1_, qm - kb_); } while (0)
    constexpr int NQL = 8;
#define SEAM_K0() do { VMWN(NQL); SWRITE_HK(0); SBAR(); } while (0)
    f32x16 pA0, pA1, pB0, pB1; bf16x8 pa0, pa1, pa2, pa3;
    SWRITE_HV(0); SBAR();
    SLOAD_H(Kh, Vh, KBASE(1));
    SBAR(); qkt<0>(pA0, pA1, K_lds, r32, hi, S.qr, TINIT(0));
    MASKT(pA0, pA1, 0); { float al0_; partialSM(pA0, pA1, negm, l_reg, al0_); }
    VMW(); SWRITE_H(1);
    __syncthreads();
#define HALF_STEP(PX0, PX1, PY0, PY1, t, KB, SB) do { float alX;                                                    \
        if ((t) + 1 < NT) { SBAR(); SLOAD_H(Kh, Vh, KBASE((t) + 1)); }     \
        SBAR(); qkt<KB>(PX0, PX1, K_lds, r32, hi, S.qr, TINIT(t));                                             \
        finishSM(PY0, PY1, l_reg, pa0, pa1, pa2, pa3); SBAR();                                                           \
        pv_tile<0>(o, vb0 + vs * SHM_V, pa0, pa1, pa2, pa3); MASKT(PX0, PX1, (t)); partialSM(PX0, PX1, negm, l_reg, alX);                                        \
        if ((t) + 1 < NT) { VMW(); SWRITE_HK(SB); SWRITE_HV(vs == 0 ? 2 : vs - 1); }     \
        RESC(alX); vs = vs == 2 ? 0 : vs + 1; __syncthreads(); } while (0)
    int vs = 0;
    for (int t = 1; t + 1 < NT; t += 2) {
        HALF_STEP(pB0, pB1, pA0, pA1, t, 1, 0);
        HALF_STEP(pA0, pA1, pB0, pB1, t + 1, 0, 1);
    }
    { SBAR(); qkt<1>(pB0, pB1, K_lds, r32, hi, S.qr, TINIT(NT - 1)); SBAR(); }
    SLOAD_H(nxt.K, nxt.V, 0); SBAR();
#pragma unroll
    for (int d0 = 0; d0 < 8; ++d0) S.qr[d0] = load8nt(nxt.Q + (size_t)(wid * QBLK + r32) * D + d0 * 16 + hi * 8);
    SBAR();
    finishSM(pA0, pA1, l_reg, pa0, pa1, pa2, pa3); SBAR();
    pv_tile<0>(o, vb0 + vs * SHM_V, pa0, pa1, pa2, pa3);
    { float alB; MASKT(pB0, pB1, NT - 1); partialSM(pB0, pB1, negm, l_reg, alB); __syncthreads(); RESC(alB);
      finishSM(pB0, pB1, l_reg, pa0, pa1, pa2, pa3); SBAR(); pv_tile<0>(o, vb0 + (vs == 2 ? 0 : vs + 1) * SHM_V, pa0, pa1, pa2, pa3); }
    SBAR(); SEAM_K0();
    if (hi == 0) li_l[r32] = l_reg; asm volatile("s_waitcnt lgkmcnt(0)" ::: "memory");
    float rli[16];
#pragma unroll
    for (int r = 0; r < 16; ++r) rli[r] = __builtin_amdgcn_rcpf(li_l[crow(r, hi)]);
    char* Ow = (char*)(cur.O + (size_t)(wid * QBLK) * OPITCH);
    unsigned obase = (unsigned)(hi * 4 * OPITCH + r32); asm volatile("" : "+v"(obase));
#pragma unroll
    for (int r = 0; r < 16; ++r) { const int orow = crow(r, hi); float ss = 0.f; const unsigned off = obase + (unsigned)(((r & 3) + 8 * (r >> 2)) * OPITCH);
#pragma unroll
        for (int d0 = 0; d0 < 4; ++d0) { const float v = o[d0][r] * rli[r]; ss = fmaf(v, v, ss);
            const float v16 = __builtin_amdgcn_fmed3f(v * 16.0f, -448.0f, 448.0f); const unsigned bq = (unsigned)__builtin_amdgcn_cvt_pk_fp8_f32(v16, v16, 0, false) & 0xffu;
            const unsigned x1 = __shfl_xor(bq, 1), x2 = __shfl_xor(bq, 2), x3 = __shfl_xor(x1, 2);
            if ((r32 & 3) == 0) *(unsigned*)(Ow + off + d0 * 32) = bq | (x1 << 8) | (x2 << 16) | (x3 << 24); }
        ss += __shfl_xor(ss, 1); ss += __shfl_xor(ss, 2); ss += __shfl_xor(ss, 4); ss += __shfl_xor(ss, 8); ss += __shfl_xor(ss, 16);
        if (r32 == 0) cur.SS[wid * QBLK + orow] = ss; }
    __syncthreads();
#undef RESC
#undef KBASE
#undef MASKT
#undef TINIT
#undef SEAM_K0
#undef HALF_STEP
}
#undef ROW
#undef VMW
#undef VMWN
#undef SLOAD_H
#undef SWRITE_HK
#undef SWRITE_HV
#undef SWRITE_H
#undef KSWZ
#undef SBAR
}

constexpr int NWAVES = 8;
#ifndef MK_N_LAUNCHES
#define MK_N_LAUNCHES 1
#endif
constexpr int N_PHASES = 11;
constexpr int N_LAUNCHES = MK_N_LAUNCHES;
static_assert(N_LAUNCHES == 1 || N_LAUNCHES == N_PHASES, "MK_N_LAUNCHES is 1 or 11");

constexpr int BATCH = 4, SEQ = 4096, DM = 2048, M = BATCH * SEQ;
constexpr int NH = 8, HD = 128, AW = 1024, RW = 1024, NRB = 16, RBD = 64;
constexpr int INC = 5120, DFF = 5504, NGU = 2 * DFF;
constexpr float EPS = 1e-6f;

constexpr size_t MiB = 1u << 20;
constexpr size_t WS_CTL = 0, CTL_ZERO_BYTES = 64 * 1024;
constexpr size_t WS_KMEAN = 512 * 1024;
constexpr size_t WS_ROPE = 1 * MiB;
constexpr size_t WS_SSA = 2 * MiB;
constexpr size_t WS_SSR = 3 * MiB;
constexpr int P0_GU2 = 264;
constexpr int DFFP = 5632;
constexpr size_t WS_SC = 7 * MiB;
constexpr size_t WS_WGU1 = 8 * MiB;
constexpr size_t WS_WD1 = 51 * MiB;
constexpr size_t WS_WIN = 73 * MiB;
constexpr size_t WS_WOUT = 93 * MiB;
constexpr size_t WS_WGU2 = 101 * MiB;
constexpr size_t WS_WD2 = 123 * MiB;
constexpr size_t WS_H = 134 * MiB;
constexpr size_t WS_ACT = 198 * MiB;
constexpr size_t WS_CG = 370 * MiB;
constexpr size_t WS_OL = 402 * MiB;
constexpr size_t WS_END = 434 * MiB;
static_assert(true, "");
constexpr size_t ACT_Q = 0, ACT_K = 32 * MiB, ACT_V = 64 * MiB, ACT_XR = 96 * MiB, ACT_GR = 128 * MiB;
static_assert(WS_WGU1 + (size_t)M * DM * 2 <= WS_WIN, "residual overlay");
static_assert(WS_WGU1 + (size_t)NGU * DM * 2 <= WS_WD1 && WS_WD1 + (size_t)DM * DFF * 2 <= WS_WIN && WS_WIN + (size_t)INC * DM * 2 <= WS_WOUT && WS_WOUT + (size_t)DM * DM * 2 <= WS_WGU2 &&
              WS_WGU2 + (size_t)NGU * DM <= WS_WD2 && WS_WD2 + (size_t)DM * DFFP <= WS_H && WS_H + (size_t)M * DM * 2 <= WS_ACT && WS_ACT + (size_t)M * DFF * 2 <= WS_END && 5 * 32 * MiB <= (size_t)M * DFF * 2 && (size_t)M * DFFP <= (size_t)M * DFF * 2, "d_ws map");
constexpr int CW_TMO = 0, CW_CODE = 1, CW_BAR = 4096;

constexpr int RING_OFF = 0, RING_BYTES = 131072;
constexpr int LDSCTL_OFF = RING_BYTES, MISC_OFF = LDSCTL_OFF + 320, SCL_OFF = LDSCTL_OFF + 1024;
constexpr int LDS_BYTES = 147456;
static_assert(SCL_OFF + 8192 <= LDS_BYTES && moba::LDS_BYTES <= RING_BYTES, "LDS map");

#define GAS __attribute__((address_space(1)))
#define LAS __attribute__((address_space(3)))
typedef unsigned short bf16;
typedef unsigned v4u __attribute__((ext_vector_type(4)));
typedef float f32x4 __attribute__((ext_vector_type(4)));
typedef short bf16x8 __attribute__((ext_vector_type(8)));
typedef GAS unsigned gu32;
typedef GAS unsigned long long gu64;
#define RLX_AGENT __ATOMIC_RELAXED, __HIP_MEMORY_SCOPE_AGENT
#define LDS_WAIT() asm volatile("s_waitcnt lgkmcnt(0)" ::: "memory")
#define VM_WAIT() asm volatile("s_waitcnt vmcnt(0)" ::: "memory")
__device__ __forceinline__ unsigned long long rt() { return __builtin_amdgcn_s_memrealtime(); }
__device__ __forceinline__ unsigned f2bf(float f) { unsigned u = __builtin_bit_cast(unsigned, f); return (u + 0x7fffu + ((u >> 16) & 1u)) >> 16; }
__device__ __forceinline__ unsigned pk2(float lo, float hi) { return f2bf(lo) | (f2bf(hi) << 16); }

#define XB_TMO      128
#define XB_XCNT(j)  (256  + 64 * (j))
#define XB_XSUB(j)  (1280 + 64 * (j))
#define XB_XGEN(j)  (2304 + 64 * (j))
#define XB_TOP      3328
#define XB_TOPGEN   3392
#define XCD_BAR_WORDS 3456
#define XB_SPIN_CAP (1u << 18)

__device__ __forceinline__ unsigned xb_ld(unsigned* p)              { return __hip_atomic_load(p, __ATOMIC_RELAXED, __HIP_MEMORY_SCOPE_AGENT); }
__device__ __forceinline__ unsigned xb_add(unsigned* p, unsigned v) { return __hip_atomic_fetch_add(p, v, __ATOMIC_RELAXED, __HIP_MEMORY_SCOPE_AGENT); }
__device__ __forceinline__ unsigned xb_xcc_id() { return (unsigned)__builtin_amdgcn_s_getreg((3 << 11) | 20) & 0xFu; }
#define XB_SPIN(cond, bar) do { unsigned _sp = 0; while (cond) { __builtin_amdgcn_s_sleep(1); \
    if ((++_sp & 255u) == 0u) { if (xb_ld(&(bar)[XB_TMO])) break; if (_sp > XB_SPIN_CAP) { atomicAdd(&(bar)[XB_TMO], 1u); break; } } } } while (0)

struct XcdBarrier {
    unsigned* bar; unsigned x;
    volatile LAS unsigned* st;
};

__device__ __forceinline__ XcdBarrier xcd_barrier_post(unsigned* bar, volatile LAS unsigned* st) {
    XcdBarrier b; b.bar = bar; b.x = xb_xcc_id(); b.st = st;
    if (threadIdx.x == 0) (void)xb_add(&bar[XB_XCNT(b.x)], 1u);
    return b;
}
__device__ __forceinline__ void xcd_barrier_complete(unsigned* bar, unsigned x, unsigned& nloc, unsigned& nx) {
    const unsigned G = gridDim.x * gridDim.y * gridDim.z;
    unsigned sum, cnt, mine, sp = 0u;
    for (;;) {
        sum = 0u; cnt = 0u; mine = 0u;
#pragma unroll
        for (unsigned j = 0; j < 16; ++j) { const unsigned c = xb_ld(&bar[XB_XCNT(j)]); sum += c; cnt += (c > 0u) ? 1u : 0u; mine = (j == x) ? c : mine; }
        if (sum == G) break;
        __builtin_amdgcn_s_sleep(1);
        if ((++sp & 255u) == 0u) { if (xb_ld(&bar[XB_TMO])) break; if (sp > XB_SPIN_CAP) { atomicAdd(&bar[XB_TMO], 1u); break; } }
    }
    nloc = mine > 0u ? mine : 1u; nx = cnt > 0u ? cnt : 1u;
}

__device__ __forceinline__ void xcd_barrier(const XcdBarrier& b) {
    asm volatile("s_waitcnt vmcnt(0)" ::: "memory");
    __syncthreads();
    if (threadIdx.x == 0) {
        unsigned* bar = b.bar;
        __builtin_amdgcn_s_waitcnt(0);
        unsigned nloc = b.st[0], nx = b.st[1];
        if (nloc == 0u) { xcd_barrier_complete(bar, b.x, nloc, nx); b.st[0] = nloc; b.st[1] = nx; }
        const unsigned old = xb_add(&bar[XB_XSUB(b.x)], 1u);
        const unsigned gen = old / nloc;
        if (old + 1u == (gen + 1u) * nloc) {
            __builtin_amdgcn_fence(__ATOMIC_RELEASE, "agent");
            asm volatile("s_waitcnt vmcnt(0)" ::: "memory");
            const unsigned og = xb_add(&bar[XB_TOP], 1u);
            const unsigned tg = og / nx;
            if (og + 1u == (tg + 1u) * nx) xb_add(&bar[XB_TOPGEN], 1u);
            else XB_SPIN(xb_ld(&bar[XB_TOPGEN]) == tg, bar);
            __builtin_amdgcn_fence(__ATOMIC_ACQUIRE, "agent");
            xb_add(&bar[XB_XGEN(b.x)], 1u);
            asm volatile("s_waitcnt vmcnt(0)" ::: "memory");
        } else {
            XB_SPIN(xb_ld(&bar[XB_XGEN(b.x)]) == gen, bar);
            __builtin_amdgcn_fence(__ATOMIC_ACQUIRE, "agent");
            asm volatile("s_waitcnt vmcnt(0)" ::: "memory");
        }
    }
    __syncthreads();
}

struct Frame {
    LAS unsigned char* lds;
    volatile LAS unsigned* MISC;
    gu32* ctl;
    int vcu, G;
};
__device__ __forceinline__ float wave_sum(float v) {
#pragma unroll
    for (int o = 1; o < 64; o <<= 1) v += __shfl_xor(v, o);
    return v;
}
__device__ __forceinline__ float wave_max(float v) {
#pragma unroll
    for (int o = 1; o < 64; o <<= 1) v = fmaxf(v, __shfl_xor(v, o));
    return v;
}
__device__ __forceinline__ unsigned pack_i8x4(f32x4 v) {
    const int a = (int)__builtin_rintf(v.x), b = (int)__builtin_rintf(v.y), c = (int)__builtin_rintf(v.z), d = (int)__builtin_rintf(v.w);
    return (unsigned)(a & 0xff) | ((unsigned)(b & 0xff) << 8) | ((unsigned)(c & 0xff) << 16) | ((unsigned)d << 24);
}
__device__ __forceinline__ float amax4(f32x4 v) { return fmaxf(fmaxf(fabsf(v.x), fabsf(v.y)), fmaxf(fabsf(v.z), fabsf(v.w))); }
__device__ __forceinline__ float bf2f(unsigned short b) { return __uint_as_float((unsigned)b << 16); }
__device__ __forceinline__ void transpose_item(const float* W, int N, int Kd, bf16* WT, int k0, int n0, int drow0, const float* ksc, LAS float* scr, int lane, bool nts) {
    { f32x4 v[8];
#pragma unroll
      for (int i = 0; i < 8; ++i) v[i] = __builtin_nontemporal_load((const f32x4*)(W + (size_t)(k0 + 8 * i + (lane >> 3)) * N + n0 + 4 * (lane & 7)));
#pragma unroll
      for (int i = 0; i < 8; ++i) { const int kk = 8 * i + (lane >> 3); f32x4 t = v[i]; if (ksc) t = t * ksc[k0 + kk]; LAS float* d = scr + kk * 33 + 4 * (lane & 7); d[0] = t.x; d[1] = t.y; d[2] = t.z; d[3] = t.w; } }
    LDS_WAIT(); asm volatile("" ::: "memory");
    const int c = lane & 7;
#pragma unroll
    for (int j = 0; j < 4; ++j) { const int n = (lane >> 3) + 8 * j; const LAS float* s = scr + (8 * c) * 33 + n;
        v4u o; o.x = pk2(s[0 * 33], s[1 * 33]); o.y = pk2(s[2 * 33], s[3 * 33]); o.z = pk2(s[4 * 33], s[5 * 33]); o.w = pk2(s[6 * 33], s[7 * 33]);
        v4u* dp = (v4u*)(WT + (size_t)(drow0 + n) * Kd + k0 + 8 * c); if (nts) __builtin_nontemporal_store(o, dp); else *dp = o; }
    LDS_WAIT(); asm volatile("" ::: "memory");
}
__device__ __forceinline__ void transpose_item_f8(const float* W, int N, int Kd, unsigned char* WT, int k0, int n0, int drow0, float sc, const float* ksc, LAS float* scr, int lane, bool nts) {
    { f32x4 v[8];
#pragma unroll
      for (int i = 0; i < 8; ++i) v[i] = __builtin_nontemporal_load((const f32x4*)(W + (size_t)(k0 + 8 * i + (lane >> 3)) * N + n0 + 4 * (lane & 7)));
#pragma unroll
      for (int i = 0; i < 8; ++i) { const int kk = 8 * i + (lane >> 3); f32x4 t = v[i] * sc; if (ksc) t = t * ksc[k0 + kk]; LAS float* d = scr + kk * 33 + 4 * (lane & 7); d[0] = t.x; d[1] = t.y; d[2] = t.z; d[3] = t.w; } }
    LDS_WAIT(); asm volatile("" ::: "memory");
    const int c = lane & 7;
#pragma unroll
    for (int j = 0; j < 4; ++j) { const int n = (lane >> 3) + 8 * j; const LAS float* s = scr + (8 * c) * 33 + n;
        typedef unsigned u32x2v __attribute__((ext_vector_type(2)));
        u32x2v o; o.x = pg8::cvt4_fp8(s[0 * 33], s[1 * 33], s[2 * 33], s[3 * 33]); o.y = pg8::cvt4_fp8(s[4 * 33], s[5 * 33], s[6 * 33], s[7 * 33]);
        u32x2v* dp = (u32x2v*)(WT + (size_t)(drow0 + n) * Kd + k0 + 8 * c); if (nts) __builtin_nontemporal_store(o, dp); else *dp = o; }
    LDS_WAIT(); asm volatile("" ::: "memory");
}
__device__ __forceinline__ void transpose_matrix_f8(Frame& F, const float* W, int K, int N, int NC, unsigned char* WT, int Kd, float sc, const float* ksc, bool gu, LAS float* scr, int gw0, int NGW, bool nts = false) {
    const int nblk = NC / 32, nitems = (K / 64) * nblk;
    for (int it = gw0; it < nitems; it += NGW) { const int kb = it / nblk, nb = it - kb * nblk, n0 = 32 * nb; int drow0 = n0;
        if (gu) { const int half = n0 >= DFF, nn = n0 - half * DFF; drow0 = 256 * (nn >> 7) + 128 * half + (nn & 127); }
        transpose_item_f8(W, N, Kd, WT, 64 * kb, n0, drow0, sc, ksc, scr, ((int)threadIdx.x & 63), nts); }
}
__device__ __forceinline__ void transpose_matrix(Frame& F, const float* W, int K, int N, int NC, bf16* WT, int Kd, const float* ksc, bool gu, LAS float* scr, int gw0, int NGW, bool nts = false) {
    const int nblk = NC / 32, nitems = (K / 64) * nblk;
    for (int it = gw0; it < nitems; it += NGW) { const int kb = it / nblk, nb = it - kb * nblk, n0 = 32 * nb; int drow0 = n0;
        if (gu) { const int half = n0 >= DFF, nn = n0 - half * DFF; drow0 = 256 * (nn >> 7) + 128 * half + (nn & 127); }
        transpose_item(W, N, Kd, WT, 64 * kb, n0, drow0, ksc, scr, ((int)threadIdx.x & 63), nts); }
}
__device__ __forceinline__ void quant_strips_i8(Frame& F, const float* W, int N, unsigned char* WT, float* sw, bool gu, int s_first, int s_end, int stride, bool nts = false) {
    const int lane = (int)threadIdx.x & 63, wave = __builtin_amdgcn_readfirstlane((int)threadIdx.x >> 6), c8 = lane & 7, r8 = lane >> 3;
    LAS float* scr = (LAS float*)(F.lds + RING_OFF + wave * 16384); LAS float* mx = (LAS float*)(F.lds + RING_OFF + 12288);
    for (int it = s_first; it < s_end; it += stride) {
        const int n0 = 32 * it; int drow0 = n0;
        if (gu) { const int half = n0 >= DFF, nn = n0 - half * DFF; drow0 = 256 * (nn >> 7) + 128 * half + (nn & 127); }
        f32x4 v[4][8]; f32x4 m4 = {0.f, 0.f, 0.f, 0.f};
#pragma unroll
        for (int sb = 0; sb < 4; ++sb)
#pragma unroll
            for (int i = 0; i < 8; ++i) v[sb][i] = __builtin_nontemporal_load((const f32x4*)(W + (size_t)(256 * wave + 64 * sb + 8 * i + r8) * N + n0 + 4 * c8));
#pragma unroll
        for (int sb = 0; sb < 4; ++sb)
#pragma unroll
            for (int i = 0; i < 8; ++i) m4 = __builtin_elementwise_max(m4, __builtin_elementwise_abs(v[sb][i]));
#pragma unroll
        for (int j = 0; j < 4; ++j) { float t = m4[j]; t = fmaxf(t, __shfl_xor(t, 8)); t = fmaxf(t, __shfl_xor(t, 16)); t = fmaxf(t, __shfl_xor(t, 32)); m4[j] = t; }
        if (r8 == 0) *(LAS f32x4*)(mx + wave * 4096 + 4 * c8) = m4;
        __syncthreads();
        f32x4 am = *(const LAS f32x4*)(mx + 4 * c8);
#pragma unroll
        for (int w2 = 1; w2 < 8; ++w2) am = __builtin_elementwise_max(am, *(const LAS f32x4*)(mx + w2 * 4096 + 4 * c8));
        f32x4 sc;
#pragma unroll
        for (int j = 0; j < 4; ++j) sc[j] = am[j] > 0.f ? 127.0f / am[j] : 0.f;
        if (wave == 0 && r8 == 0) *(f32x4*)(sw + drow0 + 4 * c8) = am * (1.0f / 127.0f);
#pragma unroll
        for (int sb = 0; sb < 4; ++sb) {
#pragma unroll
            for (int i = 0; i < 8; ++i) { const f32x4 t = v[sb][i] * sc; LAS float* d = scr + (8 * i + r8) * 33 + 4 * c8; d[0] = t.x; d[1] = t.y; d[2] = t.z; d[3] = t.w; }
            LDS_WAIT(); asm volatile("" ::: "memory");
#pragma unroll
            for (int j = 0; j < 4; ++j) { const int n = r8 + 8 * j; const LAS float* s = scr + (8 * c8) * 33 + n;
                typedef unsigned u32x2v __attribute__((ext_vector_type(2)));
                u32x2v o; o.x = pack_i8x4((f32x4){s[0 * 33], s[1 * 33], s[2 * 33], s[3 * 33]}); o.y = pack_i8x4((f32x4){s[4 * 33], s[5 * 33], s[6 * 33], s[7 * 33]});
                u32x2v* dp = (u32x2v*)(WT + (size_t)(drow0 + n) * DM + 256 * wave + 64 * sb + 8 * c8); if (nts) __builtin_nontemporal_store(o, dp); else *dp = o; }
            LDS_WAIT(); asm volatile("" ::: "memory");
        }
        __syncthreads();
    }
}
__device__ __forceinline__ void sincos_tab(double a, float& c, float& s) {
    const double k = rint(a * 0.15915494309189535); double r = fma(-k, 6.283185307179586, a); r = fma(-k, 2.4492935982947064e-16, r);
    const double r2 = r * r; double sv = 1.0, cv = 1.0;
#pragma unroll
    for (int n = 14; n >= 1; --n) { sv = 1.0 - r2 * sv * (1.0 / (double)((2 * n) * (2 * n + 1))); cv = 1.0 - r2 * cv * (1.0 / (double)((2 * n - 1) * (2 * n))); }
    s = (float)(r * sv); c = (float)cv;
}
__device__ __forceinline__ void store_row_i8(const f32x4 (&o)[8], unsigned char* hrow8, float* shrow) {
    float am = 0.f;
#pragma unroll
    for (int i = 0; i < 8; ++i) am = fmaxf(am, amax4(o[i]));
    am = wave_max(am);
    const float sc = am > 0.f ? 127.0f / am : 0.f;
#pragma unroll
    for (int i = 0; i < 8; ++i) *(unsigned*)(hrow8 + 256 * i + 4 * ((int)threadIdx.x & 63)) = pack_i8x4(o[i] * sc);
    if (((int)threadIdx.x & 63) == 0) *shrow = am * (1.0f / 127.0f);
}
__device__ __forceinline__ void rms_rows(Frame& F, const float* x, const float* g, unsigned char* hout8, float* sh) {
    const int gw = F.vcu * NWAVES + __builtin_amdgcn_readfirstlane((int)threadIdx.x >> 6), NGW = F.G * NWAVES;
    f32x4 gv[8];
#pragma unroll
    for (int i = 0; i < 8; ++i) gv[i] = *(const f32x4*)(g + 256 * i + 4 * ((int)threadIdx.x & 63));
    for (int m = gw; m < M; m += NGW) {
        const float* xr = x + (size_t)m * DM + 4 * ((int)threadIdx.x & 63); f32x4 v[8]; float s = 0.f;
#pragma unroll
        for (int i = 0; i < 8; ++i) { v[i] = __builtin_nontemporal_load((const f32x4*)(xr + 256 * i)); s += (v[i].x * v[i].x + v[i].y * v[i].y) + (v[i].z * v[i].z + v[i].w * v[i].w); }
        const float rs = 1.0f / sqrtf(wave_sum(s) * (1.0f / DM) + EPS);
#pragma unroll
        for (int i = 0; i < 8; ++i) v[i] = v[i] * rs * gv[i];
        store_row_i8(v, hout8 + (size_t)m * DM, sh + m);
    }
}
template <int HAS_H  , bool BASE_BF16, bool OUT_BF16>
__device__ __forceinline__ void norm_res_rows(Frame& F, const bf16* src, const void* basev, void* outv, void* hout, unsigned char* hout8, float* sh, const float* gpost, const float* gpre, float alpha) {
    const int gw = F.vcu * NWAVES + __builtin_amdgcn_readfirstlane((int)threadIdx.x >> 6), NGW = F.G * NWAVES;
    f32x4 gp[8], gq[8];
#pragma unroll
    for (int i = 0; i < 8; ++i) { gp[i] = *(const f32x4*)(gpost + 256 * i + 4 * ((int)threadIdx.x & 63)) * alpha; if (HAS_H) gq[i] = *(const f32x4*)(gpre + 256 * i + 4 * ((int)threadIdx.x & 63)); }
    for (int m = gw; m < M; m += NGW) {
        const bf16* sr = src + (size_t)m * DM + 4 * ((int)threadIdx.x & 63); const size_t eo = (size_t)m * DM + 4 * ((int)threadIdx.x & 63);
        f32x4 f[8], x[8]; float s = 0.f;
#pragma unroll
        for (int i = 0; i < 8; ++i) { const unsigned long long w = __builtin_nontemporal_load((const unsigned long long*)(sr + 256 * i));
            if (BASE_BF16) { const unsigned long long bw = __builtin_nontemporal_load((const unsigned long long*)((const bf16*)basev + eo + 256 * i));
                x[i] = (f32x4){__uint_as_float((unsigned)bw << 16), __uint_as_float((unsigned)bw & 0xffff0000u), __uint_as_float((unsigned)(bw >> 32) << 16), __uint_as_float((unsigned)(bw >> 32) & 0xffff0000u)}; }
            else x[i] = __builtin_nontemporal_load((const f32x4*)((const float*)basev + eo + 256 * i));
            f[i] = (f32x4){__uint_as_float((unsigned)w << 16), __uint_as_float((unsigned)w & 0xffff0000u), __uint_as_float((unsigned)(w >> 32) << 16), __uint_as_float((unsigned)(w >> 32) & 0xffff0000u)};
            s += (f[i].x * f[i].x + f[i].y * f[i].y) + (f[i].z * f[i].z + f[i].w * f[i].w); }
        const float rs = 1.0f / sqrtf(wave_sum(s) * (1.0f / DM) + EPS);
        float s1 = 0.f;
#pragma unroll
        for (int i = 0; i < 8; ++i) { x[i] = x[i] + f[i] * rs * gp[i];
            if (OUT_BF16) __builtin_nontemporal_store((unsigned long long)pk2(x[i].x, x[i].y) | ((unsigned long long)pk2(x[i].z, x[i].w) << 32), (unsigned long long*)((bf16*)outv + eo + 256 * i)); else __builtin_nontemporal_store(x[i], (f32x4*)((float*)outv + eo + 256 * i));
            s1 += (x[i].x * x[i].x + x[i].y * x[i].y) + (x[i].z * x[i].z + x[i].w * x[i].w); }
        if (HAS_H) {
            const float rs1 = 1.0f / sqrtf(wave_sum(s1) * (1.0f / DM) + EPS);
            if (HAS_H == 1 || HAS_H == 3) { bf16* ho = (bf16*)hout + (size_t)m * DM + 4 * ((int)threadIdx.x & 63);
#pragma unroll
                for (int i = 0; i < 8; ++i) { const f32x4 o = x[i] * rs1 * gq[i]; *(unsigned long long*)(ho + 256 * i) = (unsigned long long)pk2(o.x, o.y) | ((unsigned long long)pk2(o.z, o.w) << 32); } }
            if (HAS_H == 2 || HAS_H == 3) {
#pragma unroll
                for (int i = 0; i < 8; ++i) x[i] = x[i] * rs1 * gq[i];
                store_row_i8(x, (HAS_H == 2 ? (unsigned char*)hout : hout8) + (size_t)m * DM, sh + m); }
        }
    }
}

struct RecArgs { const bf16* XR; const bf16* GR; unsigned char* OUT  ; bf16* OL; bf16* CG  ; float* SSR  ;
                 const float *conv_w, *conv_b, *w_a, *b_a, *w_x, *b_x, *lam; };
__device__ __forceinline__ float sigmoidf_(float x) { return __builtin_amdgcn_rcpf(1.0f + __builtin_amdgcn_exp2f(-1.4426950408889634f * x)); }
constexpr int REC_XT = 35 * 144, REC_WAVE_LDS = 2 * REC_XT + 1024 + 2 * 1024 + 64;
static_assert(2048 + 8 * 14336 <= RING_BYTES && REC_WAVE_LDS <= 14336, "rec LDS");
__device__ __forceinline__ void rec_unit(Frame& F, const RecArgs& R, int b, int nb, int qq) {
    typedef float f32x4v __attribute__((ext_vector_type(4)));
    const int lane = (int)threadIdx.x & 63, wave = __builtin_amdgcn_readfirstlane((int)threadIdx.x >> 6), c = lane & 15, q = lane >> 4;
    const int ch = 64 * nb + 16 * qq + c;
    LAS float* sum = (LAS float*)(F.lds + RING_OFF);
    LAS unsigned char* wl = F.lds + RING_OFF + 2048 + wave * 14336;
    LAS unsigned char* gt = wl + 2 * REC_XT; LAS unsigned char* ot = gt + 1024; LAS unsigned char* ct = ot + 1024; LAS float* cinl = (LAS float*)(ct + 1024);
    bf16x8 ba[4][2], bx[4][2]; float bsa = 0.f, bsx = 0.f;
#pragma unroll
    for (int ks = 0; ks < 2; ++ks)
#pragma unroll
        for (int e = 0; e < 8; ++e) { const int k = 32 * ks + 8 * q + e; const size_t wi = ((size_t)nb * 64 + k) * 64 + 16 * qq + c; const float wa = R.w_a[wi], wx = R.w_x[wi];
            const float cbk = R.conv_b[64 * nb + k]; bsa = fmaf(cbk, wa, bsa); bsx = fmaf(cbk, wx, bsx);
#pragma unroll
            for (int tap = 0; tap < 4; ++tap) { const float cwk = R.conv_w[tap * RW + 64 * nb + k]; ba[tap][ks][e] = (short)f2bf(cwk * wa); bx[tap][ks][e] = (short)f2bf(cwk * wx); } }
    bsa += __shfl_xor(bsa, 16); bsa += __shfl_xor(bsa, 32); bsx += __shfl_xor(bsx, 16); bsx += __shfl_xor(bsx, 32);
    const float bac = R.b_a[ch] + bsa, bxc = R.b_x[ch] + bsx;
    const float lamv = R.lam[ch]; const float sp8 = -8.0f * log1pf(expf(-lamv)) * 1.4426950408889634f;
    const float cw0 = R.conv_w[ch], cw1 = R.conv_w[RW + ch], cw2 = R.conv_w[2 * RW + ch], cw3 = R.conv_w[3 * RW + ch], cbc = R.conv_b[ch];
    const size_t rowb = (size_t)b * SEQ;
    const int slot = nb * 4 + qq;
    const int trow = lane >> 1, thalf = lane & 1;
    v4u xq[5], gq;
#define REC_LOAD(tb_) do { _Pragma("unroll") for (int i_ = 0; i_ < 5; ++i_) { const int id_ = lane + 64 * i_, tt_ = (tb_) - 3 + (id_ >> 3); xq[i_] = (v4u){0u, 0u, 0u, 0u}; \
        if (id_ < 280 && tt_ >= 0) xq[i_] = *(const v4u*)(R.XR + (rowb + tt_) * RW + 64 * nb + 8 * (id_ & 7)); } \
        gq = __builtin_nontemporal_load((const v4u*)(R.GR + (rowb + (tb_) + trow) * RW + 64 * nb + 16 * qq + 8 * thalf)); } while (0)
    REC_LOAD(wave * 512);
    float st = 0.f, Pst = 1.f;
    for (int it = 0; it < 16; ++it) {
        const int tb = wave * 512 + it * 32;
        LAS unsigned char* xt = wl + (it & 1) * REC_XT;
#pragma unroll
        for (int i = 0; i < 5; ++i) { const int id = lane + 64 * i; if (id < 280) *(LAS v4u*)(xt + (id >> 3) * 144 + (id & 7) * 16) = xq[i]; }
        *(LAS v4u*)(gt + trow * 32 + thalf * 16) = gq;
        asm volatile("" ::: "memory");
        if (it + 1 < 16) REC_LOAD(tb + 32);
        f32x4v gr_[2], gi_[2];
#pragma unroll
        for (int mt = 0; mt < 2; ++mt) { gr_[mt] = (f32x4v){0.f, 0.f, 0.f, 0.f}; gi_[mt] = gr_[mt];
#pragma unroll
            for (int tap = 0; tap < 4; ++tap)
#pragma unroll
                for (int ks = 0; ks < 2; ++ks) { const bf16x8 af = *(const LAS bf16x8*)(xt + (16 * mt + c + tap) * 144 + (32 * ks + 8 * q) * 2);
                    gr_[mt] = __builtin_amdgcn_mfma_f32_16x16x32_bf16(af, ba[tap][ks], gr_[mt], 0, 0, 0); gi_[mt] = __builtin_amdgcn_mfma_f32_16x16x32_bf16(af, bx[tap][ks], gi_[mt], 0, 0, 0); } }
        float av[2][4], uv[2][4], gl[2][4], P[2], Hs[2];
#pragma unroll
        for (int mt = 0; mt < 2; ++mt) {
            float xs[7];
#pragma unroll
            for (int i = 0; i < 7; ++i) xs[i] = bf2f(*(const LAS unsigned short*)(xt + (16 * mt + 4 * q + i) * 144 + (16 * qq + c) * 2));
#pragma unroll
            for (int j = 0; j < 4; ++j) { const float xcv = fmaf(cw3, xs[j + 3], fmaf(cw2, xs[j + 2], fmaf(cw1, xs[j + 1], fmaf(cw0, xs[j], cbc))));
                const float r = sigmoidf_(gr_[mt][j] + bac), ig = sigmoidf_(gi_[mt][j] + bxc);
                const float a = __builtin_amdgcn_exp2f(r * sp8); av[mt][j] = a; uv[mt][j] = __builtin_amdgcn_sqrtf(fmaxf(1.0f - a * a, 0.f)) * (ig * xcv);
                gl[mt][j] = bf2f(*(const LAS unsigned short*)(gt + (16 * mt + 4 * q + j) * 32 + c * 2)); }
            P[mt] = (av[mt][0] * av[mt][1]) * (av[mt][2] * av[mt][3]);
            Hs[mt] = fmaf(fmaf(fmaf(uv[mt][0], av[mt][1], uv[mt][1]), av[mt][2], uv[mt][2]), av[mt][3], uv[mt][3]); }
        float sin_[2], pin_[2]; { float s_ = st, p_ = Pst;
#pragma unroll
            for (int mt = 0; mt < 2; ++mt)
#pragma unroll
                for (int q2 = 0; q2 < 4; ++q2) { const float ps = __shfl(P[mt], c + 16 * q2), hs = __shfl(Hs[mt], c + 16 * q2);
                    if (q2 == q) { sin_[mt] = s_; pin_[mt] = p_; } s_ = fmaf(ps, s_, hs); p_ *= ps; }
            st = s_; Pst = p_; }
#pragma unroll
        for (int mt = 0; mt < 2; ++mt) { float h = sin_[mt], p = pin_[mt];
#pragma unroll
            for (int j = 0; j < 4; ++j) { h = fmaf(av[mt][j], h, uv[mt][j]); p *= av[mt][j];
                const unsigned oc = pg8::cvt_pk_bf16(h * gl[mt][j], p * gl[mt][j]);
                *(LAS unsigned short*)(ot + (16 * mt + 4 * q + j) * 32 + c * 2) = (unsigned short)oc;
                *(LAS unsigned short*)(ct + (16 * mt + 4 * q + j) * 32 + c * 2) = (unsigned short)(oc >> 16); } }
        asm volatile("" ::: "memory");
        { const v4u ov = *(const LAS v4u*)(ot + trow * 32 + thalf * 16), cv = *(const LAS v4u*)(ct + trow * 32 + thalf * 16);
          *(v4u*)(R.OL + ((size_t)slot * M + rowb + tb + trow) * 16 + 8 * thalf) = ov;
          *(v4u*)(R.CG + ((size_t)slot * M + rowb + tb + trow) * 16 + 8 * thalf) = cv; }
        asm volatile("" ::: "memory");
    }
#undef REC_LOAD
    if (q == 0) { sum[(wave * 16 + c) * 2] = Pst; sum[(wave * 16 + c) * 2 + 1] = st; }
    VM_WAIT(); __syncthreads();
    float cin = 0.f;
    for (int w2 = 0; w2 < wave; ++w2) cin = fmaf(sum[(w2 * 16 + c) * 2], cin, sum[(w2 * 16 + c) * 2 + 1]);
    if (q == 0) cinl[c] = cin;
    asm volatile("" ::: "memory");
    const f32x4v ci0 = *(const LAS f32x4v*)(cinl + 8 * thalf), ci1 = *(const LAS f32x4v*)(cinl + 8 * thalf + 4);
    const float cc[8] = {ci0[0], ci0[1], ci0[2], ci0[3], ci1[0], ci1[1], ci1[2], ci1[3]};
    for (int it = 0; it < 16; ++it) { const size_t row = rowb + wave * 512 + it * 32 + trow;
        const v4u ov = *(const v4u*)(R.OL + ((size_t)slot * M + row) * 16 + 8 * thalf), cv = *(const v4u*)(R.CG + ((size_t)slot * M + row) * 16 + 8 * thalf);
        const unsigned ow[4] = {ov.x, ov.y, ov.z, ov.w}, cw_[4] = {cv.x, cv.y, cv.z, cv.w}; float o[8]; float s2 = 0.f;
#pragma unroll
        for (int e = 0; e < 4; ++e) { o[2 * e] = fmaf(cc[2 * e], __uint_as_float(cw_[e] << 16), __uint_as_float(ow[e] << 16)); o[2 * e + 1] = fmaf(cc[2 * e + 1], __uint_as_float(cw_[e] & 0xffff0000u), __uint_as_float(ow[e] & 0xffff0000u));
            s2 = fmaf(o[2 * e], o[2 * e], fmaf(o[2 * e + 1], o[2 * e + 1], s2)); }
        typedef unsigned u32x2v __attribute__((ext_vector_type(2)));
#pragma unroll
        for (int e = 0; e < 8; ++e) o[e] = __builtin_amdgcn_fmed3f(4.f * o[e], -448.0f, 448.0f);
        u32x2v w8; w8.x = pg8::cvt4_fp8(o[0], o[1], o[2], o[3]); w8.y = pg8::cvt4_fp8(o[4], o[5], o[6], o[7]);
        *(u32x2v*)(R.OUT + row * DM + AW + 64 * nb + 16 * qq + 8 * thalf) = w8;
        s2 += __shfl_xor(s2, 1);
        if (thalf == 0) R.SSR[(size_t)slot * M + row] = s2; }
    __syncthreads();
}
struct Args { const float* in[22]; float* out; unsigned char* ws; double invf[16]; int ph_lo, ph_hi, li, pad; };
__global__ void __launch_bounds__(NWAVES * 64, 2) hyb_fwd(Args args) {
    extern __shared__ __attribute__((aligned(16))) unsigned char lds[];
    Frame F;
    F.lds = (LAS unsigned char*)lds;
    F.MISC = (volatile LAS unsigned*)(F.lds + MISC_OFF);
    F.G = gridDim.x; { const int bx = blockIdx.x; F.vcu = (F.G % 8 == 0) ? (bx % 8) * (F.G / 8) + bx / 8 : bx; }
    unsigned char* ws = args.ws;
    F.ctl = (gu32*)(ws + WS_CTL);
#define GRID_BAR(seam) do { if (N_LAUNCHES != 1) { if (((int)threadIdx.x) == 0) __hip_atomic_store(F.ctl + CW_TMO, 0xBADBA0u | (unsigned)(seam), RLX_AGENT); } else { xcd_barrier(bar); } } while (0)
    const float* x = args.in[0];
    unsigned char* Wgu1 = ws + WS_WGU1; unsigned char* Wd1 = ws + WS_WD1; float* swgu1 = (float*)(ws + WS_SC); float* swgu2 = (float*)(ws + WS_SC + 65536); float* swkvxg = (float*)(ws + WS_SC + 131072); float* shrow = (float*)(ws + WS_SC + 196608); unsigned char* Wkvxg = ws + WS_WIN;   unsigned char* Wout8 = ws + WS_WOUT; unsigned char* H8B = ws + WS_CG;
    unsigned char* Wgu2 = ws + WS_WGU2; unsigned char* Wd2 = ws + WS_WD2;
    bf16* H = (bf16*)(ws + WS_H); unsigned char* H8 = ws + WS_H; bf16* ACT = (bf16*)(ws + WS_ACT); unsigned char* ACT8 = ws + WS_ACT;
    bf16* Qh = (bf16*)(ws + WS_ACT + ACT_Q); bf16* Kh = (bf16*)(ws + WS_ACT + ACT_K); bf16* Vh = (bf16*)(ws + WS_ACT + ACT_V);
    bf16* XR = (bf16*)(ws + WS_ACT + ACT_XR); bf16* GR = (bf16*)(ws + WS_ACT + ACT_GR); bf16* Y = (bf16*)(ws + WS_ACT);
    float* rope = (float*)(ws + WS_ROPE); float* kmean = (float*)(ws + WS_KMEAN); float* ssa = (float*)(ws + WS_SSA); float* ssr = (float*)(ws + WS_SSR);
    float* out = args.out; bf16* XRES = (bf16*)(ws + WS_WGU1);
    for (int u = ((int)threadIdx.x); u < (LDS_BYTES - LDSCTL_OFF) / 4; u += NWAVES * 64) ((LAS unsigned*)(F.lds + LDSCTL_OFF))[u] = 0u;
    __syncthreads();
    XcdBarrier bar; bar.bar = (unsigned*)(F.ctl + CW_BAR); bar.x = 0; bar.st = nullptr;
    if (N_LAUNCHES == 1) bar = xcd_barrier_post((unsigned*)(F.ctl + CW_BAR), F.MISC + 8);
    const int lo = args.ph_lo, hi = args.ph_hi;
#ifndef PH_MASK
#define PH_MASK 0x7ff
#endif
#define IN(k) ((((PH_MASK) >> (k)) & 1) && lo <= (k) && (k) < hi)
#define BOTH(k) (IN(k) && IN((k) + 1))

    if (IN(0)) {
        LAS float* scr = (LAS float*)(F.lds + RING_OFF + __builtin_amdgcn_readfirstlane((int)threadIdx.x >> 6) * 16384);
        const int gw = F.vcu * NWAVES + __builtin_amdgcn_readfirstlane((int)threadIdx.x >> 6), NGW = F.G * NWAVES;
        for (int i = blockIdx.x * (NWAVES * 64) + ((int)threadIdx.x); i < SEQ * 16; i += F.G * NWAVES * 64) { float c, s; sincos_tab((double)(i >> 4) * args.invf[i & 15], c, s); rope[2 * i] = c; rope[2 * i + 1] = s; }
        for (int i = blockIdx.x * (NWAVES * 64) + (int)threadIdx.x; i < BATCH * NH * 16 * 128 / 4; i += F.G * NWAVES * 64) ((f32x4*)kmean)[i] = (f32x4){0.f, 0.f, 0.f, 0.f};
        {
          const int c = (int)blockIdx.x, G = F.G, o1 = NGU / 32, o2 = o1 + INC / 32;
          quant_strips_i8(F, args.in[2], NGU, Wgu1, swgu1, true, c % G, NGU / 32, G);
          quant_strips_i8(F, args.in[6], INC, Wkvxg, swkvxg, false, ((c - o1) % G + G) % G, INC / 32, G, true);
          quant_strips_i8(F, args.in[19], NGU, Wgu2, swgu2, true, ((c - o2) % G + G) % G, P0_GU2, G, true); }
        rms_rows(F, x, args.in[1], H8, shrow);
        transpose_matrix_f8(F, args.in[16], AW, DM, DM, Wout8, DM, 32.0f, args.in[14], false, scr, gw, NGW, true);
        transpose_matrix_f8(F, args.in[16] + (size_t)AW * DM, RW, DM, DM, Wout8 + AW, DM, 32.0f, args.in[15], false, scr, gw, NGW, true);
        if (BOTH(0)) GRID_BAR(0);
    }
    if (IN(1)) {
        pg8::Gemm g{(const bf16*)H8, (const bf16*)Wgu1, M, NGU, DM / 2}; pg8::StaticOrder S; S.init(M, NGU, F.G, (int)blockIdx.x);
        pg8::EpiSwiGLUI8 E{ACT8, DFFP, shrow, swgu1, NGU / 256 - 1};
        pg8::gemm_phase<pg8::EpiSwiGLUI8, pg8::StaticOrder, pg8::NoMid, true, true, 2>(F.lds + RING_OFF, g, S, E, pg8::NoMid{});
        {
          const int rem = ((M / 256) * (NGU / 256)) % F.G, first = rem, nfill = F.G - first;
          if ((int)blockIdx.x >= first) { LAS float* scr = (LAS float*)(F.lds + RING_OFF + __builtin_amdgcn_readfirstlane((int)threadIdx.x >> 6) * 16384);
              const int gwf = ((int)blockIdx.x - first) * NWAVES + __builtin_amdgcn_readfirstlane((int)threadIdx.x >> 6);
              transpose_matrix_f8(F, args.in[3], DFF, DM, DM, Wd1, DFFP, 64.0f, nullptr, false, scr, gwf, nfill * NWAVES);
              for (int i = ((int)blockIdx.x - first) * (NWAVES * 64) + (int)threadIdx.x; i < DM * 8; i += nfill * NWAVES * 64) *(v4u*)(Wd1 + (size_t)(i >> 3) * DFFP + DFF + 16 * (i & 7)) = (v4u){0u, 0u, 0u, 0u};
              __syncthreads();
              quant_strips_i8(F, args.in[19], NGU, Wgu2, swgu2, true, P0_GU2 + (int)blockIdx.x - first, NGU / 32, nfill, true); } }
        if (BOTH(1)) GRID_BAR(1);
    }
    if (IN(2)) {
        pg8::Gemm g{(const bf16*)ACT8, (const bf16*)Wd1, M, DM, DFFP / 2}; pg8::StaticOrder S; S.init(M, DM, F.G, (int)blockIdx.x);
        pg8::EpiBf16 E{H, DM, 1.0f / 256.0f};
        pg8::gemm_phase<pg8::EpiBf16, pg8::StaticOrder, pg8::NoMid, true, true, true>(F.lds + RING_OFF, g, S, E, pg8::NoMid{});
        if (BOTH(2)) GRID_BAR(2);
    }
    if (IN(3)) {
        norm_res_rows<2, false, true>(F, H, x, XRES, H8B, nullptr, shrow, args.in[4], args.in[5], 0.5f);
        if (BOTH(3)) GRID_BAR(3);
    }
    if (IN(4)) {
        { pg8::Gemm g{(const bf16*)H8B, (const bf16*)Wkvxg, M, INC, DM / 2}; pg8::StaticOrder S; S.init(M, INC, F.G, (int)blockIdx.x);
          pg8::EpiKVXG E{ws + WS_ACT, shrow, swkvxg, rope, kmean};
          pg8::gemm_phase<pg8::EpiKVXG, pg8::StaticOrder, pg8::NoMid, true, true, 2>(F.lds + RING_OFF, g, S, E, pg8::NoMid{}); }
        if (BOTH(4)) GRID_BAR(4);
    }
    if (IN(5)) {
        char* al = (char*)lds + RING_OFF;
#ifndef NO_ATT
        for (int L = blockIdx.x; L < BATCH * NH * 8; L += F.G) {
            const int bh = (L & 7) * 4 + (L >> 6), y = (L >> 3) & 7, b = bh >> 3, h = bh & 7;
            const bf16* qb = Qh + (size_t)bh * SEQ * HD; const bf16* kb = Kh + (size_t)bh * SEQ * HD; const bf16* vb = Vh + (size_t)bh * SEQ * HD;
            moba::BlockRef r0, r1;
            r0.Q = qb + (size_t)(y * 256) * HD; r0.K = kb; r0.V = vb; r0.O = H8 + ((size_t)b * SEQ + y * 256) * DM + h * HD; r0.SS = ssa + (size_t)h * M + (size_t)b * SEQ + y * 256; r0.KM = kmean + (size_t)bh * 16 * 128; r0.P0 = y * 256;
            const int y1 = 15 - y;
            r1.Q = qb + (size_t)(y1 * 256) * HD; r1.K = kb; r1.V = vb; r1.O = H8 + ((size_t)b * SEQ + y1 * 256) * DM + h * HD; r1.SS = ssa + (size_t)h * M + (size_t)b * SEQ + y1 * 256; r1.KM = r0.KM; r1.P0 = y1 * 256;
            moba::Seam S;
            moba::moba_prime(r0, al, S);
            unsigned sel = moba::moba_select(r0, al, S);
            moba::moba_block(r0, r1, sel, al, S);
            sel = moba::moba_select(r1, al, S);
            moba::moba_block(r1, r1, sel, al, S);
            VM_WAIT(); __syncthreads();
        }
#endif
#ifndef NO_REC
        RecArgs R{XR, GR, H8, (bf16*)(ws + WS_OL), (bf16*)(ws + WS_CG), ssr, args.in[7], args.in[8], args.in[9], args.in[10], args.in[11], args.in[12], args.in[13]};
        for (int L = blockIdx.x; L < BATCH * NRB * 4; L += F.G) { const int bn = (L & 7) | ((L >> 5) << 3);
            rec_unit(F, R, bn >> 4, bn & 15, (L >> 3) & 3); }
#endif
        if (BOTH(5)) GRID_BAR(5);
    }
    if (IN(6)) {
        pg8::Gemm g{(const bf16*)H8, (const bf16*)Wout8, M, DM, DM / 2}; pg8::StaticOrder S; S.init(M, DM, F.G, (int)blockIdx.x);
        LAS float* scl = (LAS float*)(F.lds + SCL_OFF);
        { pg8::Unit u;
          for (int i0 = 0; i0 < 4; i0 += 2) { const int i = i0 + (((int)threadIdx.x) >> 8), r = ((int)threadIdx.x) & 255;
              if (S.next(i, u)) { const size_t row = (size_t)u.pm * 256 + r; float sa = 0.f, sr = 0.f;
#pragma unroll
              for (int hh = 0; hh < 8; ++hh) sa += ssa[(size_t)hh * M + row];
#pragma unroll
              for (int s = 0; s < 64; ++s) sr += ssr[(size_t)s * M + row];
              const float ra = 1.0f / sqrtf(sa * (1.0f / AW) + EPS), rr = 1.0f / sqrtf(sr * (1.0f / RW) + EPS);
              scl[(i * 256 + r) * 2] = 0.25f * ra / rr; scl[(i * 256 + r) * 2 + 1] = rr * (1.0f / 128.0f); } }
          __syncthreads(); }
        pg8::EpiRowScaleBf16 E{Y, DM, (const PG8_LAS float*)scl}; pg8::MidRowScale MH{(const PG8_LAS float*)scl};
        pg8::gemm_phase<pg8::EpiRowScaleBf16, pg8::StaticOrder, pg8::MidRowScale, true, true, true>(F.lds + RING_OFF, g, S, E, MH);
        if (BOTH(6)) GRID_BAR(6);
    }
    if (IN(7)) {
        norm_res_rows<2, true, true>(F, Y, XRES, XRES, H8, nullptr, shrow, args.in[17], args.in[18], 1.0f);
        if (BOTH(7)) GRID_BAR(7);
    }
    if (IN(8)) {
        pg8::Gemm g{(const bf16*)H8, (const bf16*)Wgu2, M, NGU, DM / 2}; pg8::StaticOrder S; S.init(M, NGU, F.G, (int)blockIdx.x);
        pg8::EpiSwiGLUI8 E{ACT8, DFFP, shrow, swgu2, NGU / 256 - 1};
        pg8::gemm_phase<pg8::EpiSwiGLUI8, pg8::StaticOrder, pg8::NoMid, true, true, 2>(F.lds + RING_OFF, g, S, E, pg8::NoMid{});
        {
          const int rem = ((M / 256) * (NGU / 256)) % F.G, first = rem, nfill = F.G - first;
          if ((int)blockIdx.x >= first) { const int wv = __builtin_amdgcn_readfirstlane((int)threadIdx.x >> 6); LAS float* scr = (LAS float*)(F.lds + RING_OFF + wv * 16384);
              transpose_matrix_f8(F, args.in[20], DFF, DM, DM, Wd2, DFFP, 64.0f, nullptr, false, scr, ((int)blockIdx.x - first) * NWAVES + wv, nfill * NWAVES);
              for (int i = ((int)blockIdx.x - first) * (NWAVES * 64) + (int)threadIdx.x; i < DM * 8; i += nfill * NWAVES * 64) *(v4u*)(Wd2 + (size_t)(i >> 3) * DFFP + DFF + 16 * (i & 7)) = (v4u){0u, 0u, 0u, 0u}; } }
        if (BOTH(8)) GRID_BAR(8);
    }
    if (IN(9)) {
        pg8::Gemm g{(const bf16*)ACT8, (const bf16*)Wd2, M, DM, DFFP / 2}; pg8::StaticOrder S; S.init(M, DM, F.G, (int)blockIdx.x);
        pg8::EpiBf16 E{H, DM, 1.0f / 256.0f};
        pg8::gemm_phase<pg8::EpiBf16, pg8::StaticOrder, pg8::NoMid, true, true, true>(F.lds + RING_OFF, g, S, E, pg8::NoMid{});
        if (BOTH(9)) GRID_BAR(9);
    }
    if (IN(10)) {
        norm_res_rows<0, true, false>(F, H, XRES, out, nullptr, nullptr, nullptr, args.in[21], nullptr, 0.5f);
    }
#undef IN
#undef BOTH
}

extern "C" void kernel_launch(void* const* d_in, const int* in_sizes, int n_in, void* d_out, int out_size, void* d_ws, size_t ws_size, hipStream_t stream) {
    static int grid = 0;
    if (grid == 0) {
        if (n_in != 22 || in_sizes[0] != M * DM || out_size != M * DM || ws_size < WS_END) { fprintf(stderr, "kernel_launch: unexpected shapes (n_in %d, in0 %d, out %d, ws %zu)\n", n_in, n_in > 0 ? in_sizes[0] : -1, out_size, ws_size); grid = -1; return; }
        int dev = 0, cus = 0, per_cu = 0;
        if (hipGetDevice(&dev) != hipSuccess || hipDeviceGetAttribute(&cus, hipDeviceAttributeMultiprocessorCount, dev) != hipSuccess) { grid = -1; return; }
        if (hipFuncSetAttribute((const void*)hyb_fwd, hipFuncAttributeMaxDynamicSharedMemorySize, LDS_BYTES) != hipSuccess) { fprintf(stderr, "kernel_launch: hipFuncSetAttribute failed\n"); grid = -1; return; }
        if (hipOccupancyMaxActiveBlocksPerMultiprocessor(&per_cu, (const void*)hyb_fwd, NWAVES * 64, LDS_BYTES) != hipSuccess || per_cu < 1)
            fprintf(stderr, "kernel_launch: note: occupancy query reports %d workgroups per CU\n", per_cu);
        (void)hipGetLastError();
        grid = cus;
    }
    if (grid < 0) return;
    if (hipMemsetAsync((char*)d_ws + WS_CTL, 0, CTL_ZERO_BYTES, stream) != hipSuccess) return;
    Args a{};
    for (int i = 0; i < 22; ++i) a.in[i] = (const float*)d_in[i];
    a.out = (float*)d_out; a.ws = (unsigned char*)d_ws;
    for (int f = 0; f < 16; ++f) a.invf[f] = pow(500000.0, -(double)f / 16.0);
    for (int li = 0; li < N_LAUNCHES; ++li) {
        a.ph_lo = (N_LAUNCHES == 1) ? 0 : li; a.ph_hi = (N_LAUNCHES == 1) ? N_PHASES : li + 1; a.li = li; a.pad = 0;
        hipLaunchKernelGGL(hyb_fwd, dim3(grid), dim3(NWAVES * 64), LDS_BYTES, stream, a);
        const hipError_t le = hipPeekAtLastError();
        if (le != hipSuccess) { fprintf(stderr, "kernel_launch: launch %d failed: %s\n", li, hipGetErrorName(le)); break; }
#ifdef DUP_PHASE
        if (N_LAUNCHES == N_PHASES && li == DUP_PHASE) hipLaunchKernelGGL(hyb_fwd, dim3(grid), dim3(NWAVES * 64), LDS_BYTES, stream, a);
#endif
    }
}
```

```cpp
#include <hip/hip_runtime.h>
#include <cstdio>
#include <cstdint>
#include <cmath>
namespace pg8 {
#define PG8_LAS __attribute__((address_space(3)))
typedef unsigned short bf16_t;
typedef short bf16x8 __attribute__((ext_vector_type(8)));
typedef float f32x4 __attribute__((ext_vector_type(4)));
typedef unsigned u32x4 __attribute__((ext_vector_type(4)));
constexpr int BM = 256, BK = 64, HALF = 128, HTB = HALF * BK * 2  , STAGE_BYTES = 8 * HTB, NXCD = 8, WGM = 4;

__host__ __device__ __forceinline__ int lds_byte(int r, int c) { const int st = (r >> 4) * 2 + (c >> 5), rr = r & 15, cc = c & 31, ob = rr * 64 + cc * 2; return st * 1024 + (ob ^ (((ob >> 9) & 1) << 5)); }
__host__ __device__ __forceinline__ void stage_rc(int b, int& R, int& C) { const int st = b / 1024, sb = b % 1024, swz = sb ^ (((sb >> 9) & 1) << 5); R = (st >> 1) * 16 + swz / 64; C = (st & 1) * 32 + (swz % 64) / 2; }
__host__ __device__ __forceinline__ int perm32(int rho) { const int n = rho >> 4, i = rho & 15; return 8 * (i >> 2) + 4 * n + (i & 3); }

struct Unit { int pm, pn; };
struct Gemm { const bf16_t* A; const bf16_t* Bt; int M, N, K; };

struct StaticOrder {
    int nM, nN, nwg, G, c;
    __host__ __device__ __forceinline__ void init(int M, int N, int G_, int c_) { nM = M / BM; nN = N / BM; nwg = nM * nN; G = G_; c = c_; }
    __host__ __device__ __forceinline__ bool next(int i, Unit& u) const {
        const long L = (long)i * G + c; if (L >= nwg) return false;
        int wgid = (int)L; { const int q = nwg / NXCD, r = nwg % NXCD, xcd = wgid % NXCD, off = wgid / NXCD; wgid = (xcd < r ? xcd * (q + 1) : r * (q + 1) + (xcd - r) * q) + off; }
        const int nig = WGM * nN, gid = wgid / nig, fm = gid * WGM, gsz = (nM - fm) < WGM ? (nM - fm) : WGM;
        u.pm = fm + ((wgid % nig) % gsz); u.pn = (wgid % nig) / gsz; return true;
    }
    __device__ __forceinline__ void a_ready(const Unit&) const {}
    __device__ __forceinline__ void done(const Unit&) const {}
};

__device__ __forceinline__ unsigned cvt_pk_bf16(float lo, float hi) { unsigned r; asm volatile("v_cvt_pk_bf16_f32 %0, %1, %2" : "=v"(r) : "v"(lo), "v"(hi)); return r; }
typedef float f32x2 __attribute__((ext_vector_type(2)));
typedef f32x4 Acc[2][2][4][2];

typedef int i32x4v __attribute__((ext_vector_type(4)));
typedef int i32x8v __attribute__((ext_vector_type(8)));
__device__ __forceinline__ i32x8v cat8(bf16x8 a, bf16x8 b) { const i32x4v x = __builtin_bit_cast(i32x4v, a), y = __builtin_bit_cast(i32x4v, b); return __builtin_shufflevector(x, y, 0, 1, 2, 3, 4, 5, 6, 7); }
__device__ __forceinline__ unsigned cvt4_fp8(float a, float b, float c, float d) { int w = __builtin_amdgcn_cvt_pk_fp8_f32(a, b, 0, false); w = __builtin_amdgcn_cvt_pk_fp8_f32(c, d, w, true); return (unsigned)w; }
struct NoMid { static constexpr bool ENABLED = false; __device__ __forceinline__ void operator()(Acc&, int, int, int) const {} };

struct EpiBf16 {
    static constexpr bool PERM = true, AFTER_DRAIN = false;
    bf16_t* O; int ldc; float sc;
    __device__ __forceinline__ void operator()(Acc& acc, const Unit& u, int ui, int wr, int wc, int fr, int fq) const {
        const int row0 = u.pm * BM + wr * 64 + fr, col0 = u.pn * BM + wc * 32 + 8 * fq;
#pragma unroll
        for (int ai = 0; ai < 2; ++ai)
#pragma unroll
            for (int m = 0; m < 4; ++m) { bf16_t* rowp = O + (size_t)(row0 + ai * HALF + m * 16) * ldc + col0;
#pragma unroll
                for (int bj = 0; bj < 2; ++bj) { const f32x4 v0 = acc[ai][bj][m][0] * sc, v1 = acc[ai][bj][m][1] * sc;
                    u32x4 w; w.x = cvt_pk_bf16(v0[0], v0[1]); w.y = cvt_pk_bf16(v0[2], v0[3]); w.z = cvt_pk_bf16(v1[0], v1[1]); w.w = cvt_pk_bf16(v1[2], v1[3]);
                    *(u32x4*)(rowp + bj * HALF) = w; } }
    }
};
struct MidRowScale {
    static constexpr bool ENABLED = true;
    const PG8_LAS float* scl;
    __device__ __forceinline__ void operator()(Acc& acc, int ui, int wr, int fr) const {
#pragma unroll
        for (int ai = 0; ai < 2; ++ai)
#pragma unroll
            for (int m = 0; m < 4; ++m) { const float s = scl[(ui * 256 + ai * HALF + wr * 64 + m * 16 + fr) * 2];
#pragma unroll
                for (int bj = 0; bj < 2; ++bj)
#pragma unroll
                    for (int n = 0; n < 2; ++n) acc[ai][bj][m][n] = acc[ai][bj][m][n] * s; }
    }
};
struct EpiRowScaleBf16 {
    static constexpr bool PERM = true, AFTER_DRAIN = false;
    bf16_t* O; int ldc; const PG8_LAS float* scl;
    __device__ __forceinline__ void operator()(Acc& acc, const Unit& u, int ui, int wr, int wc, int fr, int fq) const {
        const int row0 = u.pm * BM + wr * 64 + fr, col0 = u.pn * BM + wc * 32 + 8 * fq;
#pragma unroll
        for (int ai = 0; ai < 2; ++ai)
#pragma unroll
            for (int m = 0; m < 4; ++m) { bf16_t* rowp = O + (size_t)(row0 + ai * HALF + m * 16) * ldc + col0;
                const float s = scl[(ui * 256 + ai * HALF + wr * 64 + m * 16 + fr) * 2 + 1];
#pragma unroll
                for (int bj = 0; bj < 2; ++bj) { const f32x4 v0 = acc[ai][bj][m][0] * s, v1 = acc[ai][bj][m][1] * s;
                    u32x4 w; w.x = cvt_pk_bf16(v0[0], v0[1]); w.y = cvt_pk_bf16(v0[2], v0[3]); w.z = cvt_pk_bf16(v1[0], v1[1]); w.w = cvt_pk_bf16(v1[2], v1[3]);
                    *(u32x4*)(rowp + bj * HALF) = w; } }
    }
};
typedef int i32x4e __attribute__((ext_vector_type(4)));
__device__ __forceinline__ f32x4 acc_i2f(f32x4 a) { return __builtin_convertvector(__builtin_bit_cast(i32x4e, a), f32x4); }
struct EpiSwiGLUI8 {
    static constexpr bool PERM = true, AFTER_DRAIN = false;
    unsigned char* O; int ldc; const float* sh; const float* sw; int last_pn;
    static constexpr bool PREFETCH = true;
    struct State { f32x4 sg[2], su[2]; float shr[8]; };
    __device__ __forceinline__ void prefetch(State& st, const Unit& u, int wr, int wc, int fr, int fq) const {
        const float* swp = sw + u.pn * BM + wc * 32 + 8 * fq; const float* shp = sh + u.pm * BM + wr * 64 + fr;
        st.sg[0] = *(const f32x4*)swp; st.sg[1] = *(const f32x4*)(swp + 4); st.su[0] = *(const f32x4*)(swp + HALF); st.su[1] = *(const f32x4*)(swp + HALF + 4);
#pragma unroll
        for (int i = 0; i < 8; ++i) st.shr[i] = shp[(i >> 2) * HALF + (i & 3) * 16];
    }
    __device__ __forceinline__ void operator()(Acc& acc, const Unit& u, int ui, int wr, int wc, int fr, int fq, const State& st) const {
        const int row0 = u.pm * BM + wr * 64 + fr, col0 = u.pn * HALF + wc * 32 + 8 * fq;
        const f32x4 sg[2] = {st.sg[0], st.sg[1]}, su[2] = {st.su[0] * 4.0f, st.su[1] * 4.0f};
#pragma unroll
        for (int ai = 0; ai < 2; ++ai)
#pragma unroll
            for (int m = 0; m < 4; ++m) { const int row = row0 + ai * HALF + m * 16; unsigned char* rowp = O + (size_t)row * ldc + col0; const float shr = st.shr[ai * 4 + m];
                typedef unsigned u32x2v __attribute__((ext_vector_type(2)));
                u32x2v w;
#pragma unroll
                for (int n = 0; n < 2; ++n) { const f32x4 g = acc_i2f(acc[ai][0][m][n]) * (sg[n] * shr), uu = acc_i2f(acc[ai][1][m][n]) * (su[n] * shr);
                    f32x4 e = g * -1.4426950408889634f; e = (f32x4){__builtin_amdgcn_exp2f(e[0]), __builtin_amdgcn_exp2f(e[1]), __builtin_amdgcn_exp2f(e[2]), __builtin_amdgcn_exp2f(e[3])} + 1.0f;
                    const f32x4 r = (f32x4){__builtin_amdgcn_rcpf(e[0]), __builtin_amdgcn_rcpf(e[1]), __builtin_amdgcn_rcpf(e[2]), __builtin_amdgcn_rcpf(e[3])}, v = (g * uu) * r;
                    const unsigned q8 = cvt4_fp8(__builtin_amdgcn_fmed3f(v[0], -448.f, 448.f), __builtin_amdgcn_fmed3f(v[1], -448.f, 448.f), __builtin_amdgcn_fmed3f(v[2], -448.f, 448.f), __builtin_amdgcn_fmed3f(v[3], -448.f, 448.f));
                    if (n == 0) w.x = q8; else w.y = q8; }
                *(u32x2v*)rowp = w; if (u.pn == last_pn) *(u32x2v*)(rowp + HALF) = (u32x2v){0u, 0u}; }
    }
};
struct EpiKVXG {
    static constexpr bool PERM = true, AFTER_DRAIN = false;
    unsigned char* base5; const float* sh; const float* sw; const float* rope; float* kmean;
    __device__ __forceinline__ void operator()(Acc& acc, const Unit& u, int ui, int wr, int wc, int fr, int fq) const {
        const int region = u.pn >> 2, sub = u.pn & 3;
        const float qsc = region == 0 ? 0.12751743074602467f : 1.0f;
        { const float* swp = sw + u.pn * BM + wc * 32 + 8 * fq;
#pragma unroll
          for (int bj = 0; bj < 2; ++bj) { const f32x4 s0 = *(const f32x4*)(swp + bj * HALF), s1 = *(const f32x4*)(swp + bj * HALF + 4);
#pragma unroll
              for (int ai = 0; ai < 2; ++ai)
#pragma unroll
                  for (int m = 0; m < 4; ++m) { const float shr = sh[u.pm * BM + wr * 64 + fr + ai * HALF + m * 16] * qsc;
                      acc[ai][bj][m][0] = acc_i2f(acc[ai][bj][m][0]) * (s0 * shr); acc[ai][bj][m][1] = acc_i2f(acc[ai][bj][m][1]) * (s1 * shr); } } }
        bf16_t* dst = (bf16_t*)(base5 + (size_t)region * (32u << 20));
        const int b = u.pm >> 4, blk = u.pm & 15, s0 = blk * 256 + wr * 64 + fr;
        if (region <= 1) {
            bf16_t* base = dst + ((size_t)(b * 8 + sub * 2) * 4096 + s0) * 128 + wc * 32 + 8 * fq;
            f32x4 ks[2][2];
#pragma unroll
            for (int bj = 0; bj < 2; ++bj)
#pragma unroll
                for (int n = 0; n < 2; ++n) ks[bj][n] = (f32x4){0.f, 0.f, 0.f, 0.f};
            if (wc == 0) {
                const float sgn = fq < 2 ? -1.0f : 1.0f;
                const float* rp = rope + ((size_t)s0 * 16 + 8 * (fq & 1)) * 2;
#pragma unroll
                for (int ai = 0; ai < 2; ++ai)
#pragma unroll
                    for (int m = 0; m < 4; ++m) { const f32x4* cs = (const f32x4*)(rp + (size_t)(ai * HALF + m * 16) * 32);
#pragma unroll
                        for (int bj = 0; bj < 2; ++bj) { f32x4 o[2];
#pragma unroll
                            for (int n = 0; n < 2; ++n) { const f32x4 ca = cs[2 * n], cb = cs[2 * n + 1]; const f32x4 v = acc[ai][bj][m][n];
                                const f32x4 p = (f32x4){__shfl_xor(v[0], 32), __shfl_xor(v[1], 32), __shfl_xor(v[2], 32), __shfl_xor(v[3], 32)};
                                o[n] = (f32x4){fmaf(sgn * p[0], ca[1], v[0] * ca[0]), fmaf(sgn * p[1], ca[3], v[1] * ca[2]), fmaf(sgn * p[2], cb[1], v[2] * cb[0]), fmaf(sgn * p[3], cb[3], v[3] * cb[2])}; }
                            u32x4 w; w.x = cvt_pk_bf16(o[0][0], o[0][1]); w.y = cvt_pk_bf16(o[0][2], o[0][3]); w.z = cvt_pk_bf16(o[1][0], o[1][1]); w.w = cvt_pk_bf16(o[1][2], o[1][3]);
                            *(u32x4*)(base + (size_t)bj * 4096 * 128 + (size_t)(ai * HALF + m * 16) * 128) = w;
                            ks[bj][0] += o[0]; ks[bj][1] += o[1]; } }
            } else {
#pragma unroll
                for (int ai = 0; ai < 2; ++ai)
#pragma unroll
                    for (int m = 0; m < 4; ++m)
#pragma unroll
                        for (int bj = 0; bj < 2; ++bj) { const f32x4 v0 = acc[ai][bj][m][0], v1 = acc[ai][bj][m][1];
                            u32x4 w; w.x = cvt_pk_bf16(v0[0], v0[1]); w.y = cvt_pk_bf16(v0[2], v0[3]); w.z = cvt_pk_bf16(v1[0], v1[1]); w.w = cvt_pk_bf16(v1[2], v1[3]);
                            *(u32x4*)(base + (size_t)bj * 4096 * 128 + (size_t)(ai * HALF + m * 16) * 128) = w;
                            ks[bj][0] += v0; ks[bj][1] += v1; }
            }
            if (region == 1)
#pragma unroll
            for (int bj = 0; bj < 2; ++bj) { float* kd = kmean + ((size_t)(b * 8 + sub * 2 + bj) * 16 + blk) * 128 + wc * 32 + 8 * fq;
#pragma unroll
                for (int n = 0; n < 2; ++n)
#pragma unroll
                    for (int j = 0; j < 4; ++j) { float t = ks[bj][n][j]; t += __shfl_xor(t, 1); t += __shfl_xor(t, 2); t += __shfl_xor(t, 4); t += __shfl_xor(t, 8);
                        if (fr == 0) unsafeAtomicAdd(kd + 4 * n + j, t); } }
            return;
        }
        bf16_t* base = region == 2 ? dst + ((size_t)(b * 8 + sub * 2) * 4096 + s0) * 128 + wc * 32 + 8 * fq : dst + ((size_t)u.pm * BM + wr * 64 + fr) * 1024 + sub * BM + wc * 32 + 8 * fq;
        const size_t rstep = region == 2 ? 128 : 1024, bstep = region == 2 ? (size_t)4096 * 128 : 128;
#pragma unroll
        for (int ai = 0; ai < 2; ++ai)
#pragma unroll
            for (int m = 0; m < 4; ++m)
#pragma unroll
                for (int bj = 0; bj < 2; ++bj) { const f32x4 v0 = acc[ai][bj][m][0], v1 = acc[ai][bj][m][1];
                    u32x4 w; w.x = cvt_pk_bf16(v0[0], v0[1]); w.y = cvt_pk_bf16(v0[2], v0[3]); w.z = cvt_pk_bf16(v1[0], v1[1]); w.w = cvt_pk_bf16(v1[2], v1[3]);
                    *(u32x4*)(base + (size_t)bj * bstep + (size_t)(ai * HALF + m * 16) * rstep) = w; }
    }
};

template <class E, class = void> struct epi_prefetch { static constexpr bool value = false; };
template <class E> struct epi_prefetch<E, decltype((void)E::PREFETCH)> { static constexpr bool value = E::PREFETCH; };
template <class E, bool P> struct epi_state { };
template <class E> struct epi_state<E, true> { typename E::State s; };
template <class Epi, class Sched, class Mid, bool ALIGN_EPI = false, bool SP2 = false, int MODE = 0  >
__device__ __forceinline__ void gemm_phase(PG8_LAS unsigned char* lds, const Gemm g, const Sched& S, const Epi& E, const Mid& MH) {
    const int tid = threadIdx.x, wid = __builtin_amdgcn_readfirstlane(tid >> 6), lane = tid & 63, wr = wid >> 2, wc = wid & 3, fr = lane & 15, fq = lane >> 4;
    const int K = g.K, nt = K / BK;
    unsigned voffA[2], voffB[2];
#pragma unroll
    for (int i = 0; i < 2; ++i) { int R, C; stage_rc(tid * 16 + i * 8192, R, C); const int Rb = Epi::PERM ? ((R & ~31) + perm32(R & 31)) : R;
        voffA[i] = (unsigned)(R * K + C) * 2u; voffB[i] = (unsigned)(Rb * K + C) * 2u; }
    const size_t kstep = (size_t)(BK * 2);
    const size_t hstep = (size_t)HALF * K * 2;
    const size_t tstep = 2 * hstep;
    const unsigned ldsw = (unsigned)wid * 1024u;
    const int aoff = lds_byte(wr * 64 + fr, fq * 8), boff = lds_byte(wc * 32 + fr, fq * 8);
#define PG8_SA(b, h) (((b) * 2 + (h)) * HTB)
#define PG8_SB(b, h) ((4 + (b) * 2 + (h)) * HTB)
#define PG8_STAGE(bufoff, gbase, voff) do { _Pragma("unroll") for (int _i = 0; _i < 2; ++_i) \
        __builtin_amdgcn_global_load_lds((const unsigned*)((const char*)(gbase) + (voff)[_i]), (PG8_LAS unsigned*)(lds + (bufoff) + ldsw + _i * 8192), 16, 0, 0); } while (0)
#define PG8_LDA(dst, b, h) do { _Pragma("unroll") for (int m = 0; m < 4; ++m) _Pragma("unroll") for (int k = 0; k < 2; ++k) dst[m][k] = *(const PG8_LAS bf16x8*)(lds + PG8_SA(b, h) + aoff + m * 2048 + k * 1024); } while (0)
#define PG8_LDB(dst, b, h) do { _Pragma("unroll") for (int n = 0; n < 2; ++n) _Pragma("unroll") for (int k = 0; k < 2; ++k) dst[n][k] = *(const PG8_LAS bf16x8*)(lds + PG8_SB(b, h) + boff + n * 2048 + k * 1024); } while (0)
#define PG8_MMA(ai, bj, At, Bt) do { __builtin_amdgcn_s_setprio(1); if constexpr (MODE == 1) { _Pragma("unroll") for (int m = 0; m < 4; ++m) _Pragma("unroll") for (int n = 0; n < 2; ++n) \
        { const i32x8v a8_ = cat8(Bt[n][0], Bt[n][1]), b8_ = cat8(At[m][0], At[m][1]); asm volatile("v_mfma_f32_16x16x128_f8f6f4 %0, %1, %2, %0" : "+v"(acc[ai][bj][m][n]) : "v"(a8_), "v"(b8_)); } } \
        else if constexpr (MODE == 2) { _Pragma("unroll") for (int m = 0; m < 4; ++m) _Pragma("unroll") for (int n = 0; n < 2; ++n) _Pragma("unroll") for (int k = 0; k < 2; ++k) \
        acc[ai][bj][m][n] = __builtin_bit_cast(f32x4, __builtin_amdgcn_mfma_i32_16x16x64_i8(__builtin_bit_cast(i32x4v, Bt[n][k]), __builtin_bit_cast(i32x4v, At[m][k]), __builtin_bit_cast(i32x4v, acc[ai][bj][m][n]), 0, 0, 0)); } \
        else { _Pragma("unroll") for (int m = 0; m < 4; ++m) _Pragma("unroll") for (int n = 0; n < 2; ++n) _Pragma("unroll") for (int k = 0; k < 2; ++k) \
        acc[ai][bj][m][n] = __builtin_amdgcn_mfma_f32_16x16x32_bf16(Bt[n][k], At[m][k], acc[ai][bj][m][n], 0, 0, 0); } __builtin_amdgcn_s_setprio(0); } while (0)
#define PG8_WAIT_V(n) asm volatile("s_waitcnt vmcnt(" #n ")" ::: "memory")
#define PG8_WAIT_L(n) asm volatile("s_waitcnt lgkmcnt(" #n ")" ::: "memory")
#define PG8_BAR __builtin_amdgcn_s_barrier()
#define PG8_SCHED __builtin_amdgcn_sched_barrier(0)
    Unit cur, nxt; int ui = 0;
    if (!S.next(0, cur)) return;
    epi_state<Epi, epi_prefetch<Epi>::value> est;
    Acc acc;
#pragma unroll
    for (int a = 0; a < 2; ++a)
#pragma unroll
        for (int b = 0; b < 2; ++b)
#pragma unroll
            for (int m = 0; m < 4; ++m)
#pragma unroll
                for (int n = 0; n < 2; ++n) acc[a][b][m][n] = (f32x4){0.f, 0.f, 0.f, 0.f};
    bf16x8 At[4][2], B0[2][2], B1[2][2];
    const char* cA = (const char*)g.A + (size_t)cur.pm * tstep; const char* cB = (const char*)g.Bt + (size_t)cur.pn * tstep;
    S.a_ready(cur);
    if constexpr (SP2) {
        PG8_STAGE(PG8_SB(0, 0), cB, voffB); PG8_STAGE(PG8_SB(0, 1), cB + hstep, voffB); PG8_STAGE(PG8_SA(0, 0), cA, voffA); PG8_STAGE(PG8_SA(0, 1), cA + hstep, voffA);
        if (wr == 1) PG8_BAR;
        PG8_WAIT_V(2); PG8_BAR;
        PG8_STAGE(PG8_SB(1, 0), cB + kstep, voffB); PG8_STAGE(PG8_SA(1, 0), cA + kstep, voffA); PG8_STAGE(PG8_SB(1, 1), cB + hstep + kstep, voffB);
        PG8_WAIT_V(6); PG8_BAR;
    } else {
        PG8_STAGE(PG8_SB(0, 0), cB, voffB); PG8_STAGE(PG8_SA(0, 0), cA, voffA); PG8_STAGE(PG8_SB(0, 1), cB + hstep, voffB); PG8_STAGE(PG8_SA(0, 1), cA + hstep, voffA);
        if (wr == 1) PG8_BAR;
        PG8_WAIT_V(4); PG8_BAR;
        PG8_STAGE(PG8_SB(1, 0), cB + kstep, voffB); PG8_STAGE(PG8_SA(1, 0), cA + kstep, voffA); PG8_STAGE(PG8_SB(1, 1), cB + hstep + kstep, voffB);
        PG8_WAIT_V(6); PG8_BAR;
    }
    for (;;) {
        const bool has_next = S.next(ui + 1, nxt);
        const char* nA = has_next ? (const char*)g.A + (size_t)nxt.pm * tstep : cA; const char* nB = has_next ? (const char*)g.Bt + (size_t)nxt.pn * tstep : cB;
        for (int t = 0; t < nt; t += 2) {
            const bool last = (t == nt - 2);
            const char* a1 = cA + (size_t)(t + 1) * kstep;
            const char* a2 = last ? nA : cA + (size_t)(t + 2) * kstep; const char* b2 = last ? nB : cB + (size_t)(t + 2) * kstep;
            const char* a3 = a2 + kstep; const char* b3 = b2 + kstep;
            if (last && has_next) S.a_ready(nxt);
            if constexpr (Mid::ENABLED) { if (t == (nt >> 1)) { if constexpr (MODE == 1) asm volatile("s_nop 15\n\ts_nop 15" ::: "memory"); MH(acc, ui, wr, fr); } }
            if constexpr (SP2) {
            PG8_LDB(B0, 0, 0); PG8_LDB(B1, 0, 1); PG8_SCHED; PG8_LDA(At, 0, 0); PG8_STAGE(PG8_SA(1, 1), a1 + hstep, voffA);
            PG8_WAIT_V(8); PG8_WAIT_L(0); PG8_BAR; PG8_MMA(0, 0, At, B0); PG8_MMA(0, 1, At, B1); PG8_BAR; PG8_SCHED;
            PG8_LDA(At, 0, 1); PG8_STAGE(PG8_SB(0, 0), b2, voffB); PG8_STAGE(PG8_SB(0, 1), b2 + hstep, voffB); PG8_STAGE(PG8_SA(0, 0), a2, voffA);
            PG8_WAIT_V(8); PG8_WAIT_L(0); PG8_BAR; PG8_MMA(1, 0, At, B0); PG8_MMA(1, 1, At, B1); PG8_BAR; PG8_SCHED;
            PG8_LDB(B0, 1, 0); PG8_LDB(B1, 1, 1); PG8_SCHED; PG8_LDA(At, 1, 0); PG8_STAGE(PG8_SA(0, 1), a2 + hstep, voffA);
            PG8_WAIT_V(8); PG8_WAIT_L(0); PG8_BAR; PG8_MMA(0, 0, At, B0); PG8_MMA(0, 1, At, B1); PG8_BAR; PG8_SCHED;
            PG8_LDA(At, 1, 1); PG8_STAGE(PG8_SB(1, 0), b3, voffB); PG8_STAGE(PG8_SB(1, 1), b3 + hstep, voffB); PG8_STAGE(PG8_SA(1, 0), a3, voffA);
            PG8_WAIT_V(8); PG8_WAIT_L(0); PG8_BAR; PG8_MMA(1, 0, At, B0); PG8_MMA(1, 1, At, B1); PG8_BAR; PG8_SCHED;
            } else {
            PG8_LDB(B0, 0, 0); PG8_SCHED; PG8_LDA(At, 0, 0); PG8_STAGE(PG8_SA(1, 1), a1 + hstep, voffA);
            PG8_WAIT_L(8); PG8_BAR; PG8_WAIT_L(0); PG8_MMA(0, 0, At, B0); PG8_BAR; PG8_SCHED;
            PG8_LDB(B1, 0, 1); PG8_STAGE(PG8_SB(0, 0), b2, voffB);
            PG8_BAR; PG8_WAIT_L(0); PG8_MMA(0, 1, At, B1); PG8_BAR;
            PG8_LDA(At, 0, 1); PG8_STAGE(PG8_SA(0, 0), a2, voffA);
            PG8_BAR; PG8_WAIT_L(0); PG8_MMA(1, 0, At, B0); PG8_BAR; PG8_SCHED;
            PG8_STAGE(PG8_SB(0, 1), b2 + hstep, voffB);
            PG8_WAIT_V(6); PG8_BAR; PG8_MMA(1, 1, At, B1); PG8_BAR;
            PG8_LDB(B0, 1, 0); PG8_SCHED; PG8_LDA(At, 1, 0); PG8_STAGE(PG8_SA(0, 1), a2 + hstep, voffA);
            PG8_WAIT_L(8); PG8_BAR; PG8_WAIT_L(0); PG8_MMA(0, 0, At, B0); PG8_BAR; PG8_SCHED;
            PG8_LDB(B1, 1, 1); PG8_STAGE(PG8_SB(1, 0), b3, voffB);
            PG8_BAR; PG8_WAIT_L(0); PG8_MMA(0, 1, At, B1); PG8_BAR;
            PG8_LDA(At, 1, 1); PG8_STAGE(PG8_SA(1, 0), a3, voffA);
            PG8_BAR; PG8_WAIT_L(0); PG8_MMA(1, 0, At, B0); PG8_BAR; PG8_SCHED;
            PG8_STAGE(PG8_SB(1, 1), b3 + hstep, voffB);
            PG8_WAIT_V(6); PG8_BAR; PG8_MMA(1, 1, At, B1); PG8_BAR;
            }
        }
        if constexpr (epi_prefetch<Epi>::value) E.prefetch(est.s, cur, wr, wc, fr, fq);
        if constexpr (MODE == 1) asm volatile("s_nop 15\n\ts_nop 15" ::: "memory");
        if constexpr (ALIGN_EPI) { if (wr == 0) PG8_BAR; }
        if constexpr (epi_prefetch<Epi>::value) E(acc, cur, ui, wr, wc, fr, fq, est.s); else E(acc, cur, ui, wr, wc, fr, fq);
        if (!has_next) break;
#pragma unroll
        for (int a = 0; a < 2; ++a)
#pragma unroll
            for (int b = 0; b < 2; ++b)
#pragma unroll
                for (int m = 0; m < 4; ++m)
#pragma unroll
                    for (int n = 0; n < 2; ++n) acc[a][b][m][n] = (f32x4){0.f, 0.f, 0.f, 0.f};
        cur = nxt; cA = nA; cB = nB; ++ui;
        if constexpr (ALIGN_EPI) { if (wr == 1) PG8_BAR; }
    }
    PG8_WAIT_V(0);
    if constexpr (!ALIGN_EPI) { if (wr == 0) PG8_BAR; }
    PG8_BAR;
#undef PG8_SA
#undef PG8_SB
#undef PG8_STAGE
#undef PG8_LDA
#undef PG8_LDB
#undef PG8_MMA
#undef PG8_WAIT_V
#undef PG8_WAIT_L
#undef PG8_BAR
#undef PG8_SCHED
}
}

namespace moba {
constexpr int D = 128, SKV = 4096, OPITCH = 2048;
constexpr float SCALE = 0.08838834764831845f;
constexpr float THR = 8.f;
constexpr int NW = 8, QBLK = 32, KVBLK = 64, QB = NW * QBLK;
constexpr int SHM_V = KVBLK * D * 2, SHM_K = KVBLK * 272;
constexpr int NVS = 3;
constexpr int LDS_WS = NVS * SHM_V + 2 * SHM_K, LDS_KM = LDS_WS + NW * 64 * 4, LDS_BYTES = LDS_KM + 16 * 128 * 4;
typedef unsigned short bf16;
typedef short bf16x8 __attribute__((ext_vector_type(8)));
typedef short s16x4 __attribute__((ext_vector_type(4)));
typedef float f32x16 __attribute__((ext_vector_type(16)));
typedef float f32x4 __attribute__((ext_vector_type(4)));
typedef float f32x2 __attribute__((ext_vector_type(2)));
typedef unsigned u32x4 __attribute__((ext_vector_type(4)));

constexpr int KPITCH = 272;
#define KSWZ(row, colB) ((row) * KPITCH + (colB))
#define SBAR() __builtin_amdgcn_sched_barrier(0)
__device__ __forceinline__ int v_st(int k, int c) { const int kk = k;     return ((kk >> 3) * 4 + (c >> 5)) * 512 + ((kk & 7) * 32 + (c & 31)) * 2; }
__device__ __forceinline__ int v_rd_base(int lane) { return ((lane & 3) << 3) | (((lane >> 2) & 3) << 6) | (((lane >> 4) & 1) << 5) | (((lane >> 5) & 1) << 8); }
constexpr int v_rd_off(int d0, int ks, int half) { return d0 * 512 + ks * 4096 + half * 2048; }
__device__ __forceinline__ int crow(int r, int hi) { return (r & 3) + 8 * (r >> 2) + 4 * hi; }
__device__ __forceinline__ unsigned cvtpk(float lo, float hi) { unsigned r; asm volatile("v_cvt_pk_bf16_f32 %0, %1, %2" : "=v"(r) : "v"(lo), "v"(hi)); return r; }
__device__ __forceinline__ bf16x8 load8(const bf16* p) { return *reinterpret_cast<const bf16x8*>(p); }
__device__ __forceinline__ bf16x8 load8nt(const bf16* p) { return __builtin_nontemporal_load(reinterpret_cast<const bf16x8*>(p)); }
__device__ __forceinline__ void mask_tile(f32x16& p0, f32x16& p1, int dq) {
    const float NEG = -__builtin_inff();
#define MT1(P, r, cc) do { float t_ = P[r]; asm volatile("v_cmp_gt_i32_e32 vcc, %2, %1\n\tv_cndmask_b32_e32 %0, %0, %3, vcc" : "+v"(t_) : "v"(dq), "n"(cc), "v"(NEG) : "vcc"); P[r] = t_; } while (0)
#define MT2(r) do { MT1(p0, r, ((r) & 3) + 8 * ((r) >> 2)); MT1(p1, r, ((r) & 3) + 8 * ((r) >> 2) + 32); } while (0)
    MT2(0); MT2(1); MT2(2); MT2(3); MT2(4); MT2(5); MT2(6); MT2(7); MT2(8); MT2(9); MT2(10); MT2(11); MT2(12); MT2(13); MT2(14); MT2(15);
#undef MT2
#undef MT1
}
constexpr float THR2 = THR * 1.4426950408889634f;
__device__ __forceinline__ void partialSM(f32x16& p0, f32x16& p1, float& negm, float& l_reg, float& alpha) {
    float pmax = fmaxf(p0[0], p0[1]); for (int r = 2; r < 16; ++r) pmax = fmaxf(pmax, p0[r]); for (int r = 0; r < 16; ++r) pmax = fmaxf(pmax, p1[r]);
    { auto rr = __builtin_amdgcn_permlane32_swap(__float_as_uint(pmax), __float_as_uint(pmax), false, false);
      pmax = fmaxf(__uint_as_float(rr[0]), __uint_as_float(rr[1])); }
    const float NINF = -__builtin_inff();
    const bool sb = l_reg > 0.f;
    alpha = 1.f;
    if (__builtin_expect(!__all(pmax <= (sb ? THR2 : NINF)), 0)) {
        const float mc = pmax - negm;
        const float mold = sb ? -negm : NINF;
        const float mnew = fmaxf(mold, mc);
        const bool seen = mnew > NINF;
        const float delta = seen ? mnew + negm : 0.f;
        if (sb) alpha = __builtin_amdgcn_exp2f(mold - mnew);
        if (seen) negm = -mnew;
        l_reg *= alpha;
        for (int r = 0; r < 16; ++r) p0[r] -= delta; for (int r = 0; r < 16; ++r) p1[r] -= delta;
    }
    for (int r = 0; r < 16; ++r) p0[r] = __builtin_amdgcn_exp2f(p0[r]);
}
__device__ __forceinline__ void finishSM(f32x16& p0, f32x16& p1, float& l_reg, bf16x8& pa0, bf16x8& pa1, bf16x8& pa2, bf16x8& pa3) {
    for (int r = 0; r < 16; ++r) p1[r] = __builtin_amdgcn_exp2f(p1[r]);
    f32x2 s2 = {p0[0], p0[1]};
    for (int i = 1; i < 8; ++i) s2 += (f32x2){p0[2 * i], p0[2 * i + 1]};
    for (int i = 0; i < 8; ++i) s2 += (f32x2){p1[2 * i], p1[2 * i + 1]};
    float ps = s2[0] + s2[1];
    { auto rr = __builtin_amdgcn_permlane32_swap(__float_as_uint(ps), __float_as_uint(ps), false, false);
      ps = __uint_as_float(rr[0]) + __uint_as_float(rr[1]); }
    l_reg += ps;
#define PK4(P, B_, OUT) do { u32x4 w = {cvtpk(P[B_+0], P[B_+1]), cvtpk(P[B_+2], P[B_+3]), cvtpk(P[B_+4], P[B_+5]), cvtpk(P[B_+6], P[B_+7])}; OUT = *reinterpret_cast<bf16x8*>(&w); } while (0)
    PK4(p0, 0, pa0); PK4(p0, 8, pa1); PK4(p1, 0, pa2); PK4(p1, 8, pa3);
#undef PK4
}
template <int KB>
__device__ __forceinline__ void qkt(f32x16& p0, f32x16& p1, const char* K_lds, int r32, int hi, const bf16x8* qr, float init) {
    for (int r = 0; r < 16; ++r) { p0[r] = init; p1[r] = init; }
    const char* kb = K_lds + KB * SHM_K + KSWZ(r32, hi * 16);
#pragma unroll
    for (int d0 = 0; d0 < 8; ++d0) { const char* a = kb + d0 * 32;
        bf16x8 b0 = *reinterpret_cast<const bf16x8*>(a);
        bf16x8 b1 = *reinterpret_cast<const bf16x8*>(a + 32 * KPITCH);
        p0 = __builtin_amdgcn_mfma_f32_32x32x16_bf16(b0, qr[d0], p0, 0, 0, 0);
        p1 = __builtin_amdgcn_mfma_f32_32x32x16_bf16(b1, qr[d0], p1, 0, 0, 0); }
}
template <int VB>
__device__ __forceinline__ void pv_tile(f32x16* o, int vb0, bf16x8 pa0, bf16x8 pa1, bf16x8 pa2, bf16x8 pa3) {
#define TRRD(dst, off) asm volatile("ds_read_b64_tr_b16 %0, %1 offset:%2" : "=&v"(dst) : "v"(vb0), "i"(off) : "memory")
#define PV_D0(d0) do { s16x4 l0, l1, l2, l3, h0, h1, h2, h3; constexpr int b_ = VB * SHM_V + v_rd_off(d0, 0, 0);     \
        TRRD(l0, b_); TRRD(h0, b_ + 2048); TRRD(l1, b_ + 4096); TRRD(h1, b_ + 6144); TRRD(l2, b_ + 8192); TRRD(h2, b_ + 10240); TRRD(l3, b_ + 12288); TRRD(h3, b_ + 14336); \
        asm volatile("s_waitcnt lgkmcnt(0)" ::: "memory"); SBAR();                 \
        o[d0] = __builtin_amdgcn_mfma_f32_32x32x16_bf16(pa0, (bf16x8){l0[0], l0[1], l0[2], l0[3], h0[0], h0[1], h0[2], h0[3]}, o[d0], 0, 0, 0);   \
        o[d0] = __builtin_amdgcn_mfma_f32_32x32x16_bf16(pa1, (bf16x8){l1[0], l1[1], l1[2], l1[3], h1[0], h1[1], h1[2], h1[3]}, o[d0], 0, 0, 0);   \
        o[d0] = __builtin_amdgcn_mfma_f32_32x32x16_bf16(pa2, (bf16x8){l2[0], l2[1], l2[2], l2[3], h2[0], h2[1], h2[2], h2[3]}, o[d0], 0, 0, 0);   \
        o[d0] = __builtin_amdgcn_mfma_f32_32x32x16_bf16(pa3, (bf16x8){l3[0], l3[1], l3[2], l3[3], h3[0], h3[1], h3[2], h3[3]}, o[d0], 0, 0, 0); } while (0)
    PV_D0(0); PV_D0(1); PV_D0(2); PV_D0(3);
#undef PV_D0
#undef TRRD
}
struct BlockRef { const bf16* Q; const bf16* K; const bf16* V; unsigned char* O; float* SS; const float* KM; int P0; };
struct Seam { bf16x8 qr[8]; bf16x8 st_v0, st_v1, st_k0, st_k1; };
#define ROW(p, k0, rr) ((p) + (size_t)((k0) + (rr)) * D + sc)
#define VMW() asm volatile("s_waitcnt vmcnt(0)" ::: "memory")
#define VMWN(n) asm volatile("s_waitcnt vmcnt(%0)" :: "i"(n) : "memory")
#define SLOAD_H(Kp, Vp, k0) do { S.st_v0 = load8(ROW(Vp, k0, sr)); S.st_v1 = load8(ROW(Vp, k0, 32 + sr));              \
                         S.st_k0 = load8(ROW(Kp, k0, sr)); S.st_k1 = load8(ROW(Kp, k0, 32 + sr)); } while (0)
#define SWRITE_HK(bf) do { *(bf16x8*)(K_lds + (bf) * SHM_K + kws) = S.st_k0; *(bf16x8*)(K_lds + (bf) * SHM_K + kws + 32 * KPITCH) = S.st_k1; } while (0)
#define SWRITE_HV(bf) do { *(bf16x8*)(V_lds + (bf) * SHM_V + vst0) = S.st_v0; *(bf16x8*)(V_lds + (bf) * SHM_V + vst1) = S.st_v1; } while (0)
#define SWRITE_H(bf) do { SWRITE_HV(bf); SWRITE_HK(bf); } while (0)
__device__ __forceinline__ void moba_prime(const BlockRef& cur, char* lds, Seam& S) {
    int tid_o = threadIdx.x; asm volatile("" : "+v"(tid_o));
    const int tid = tid_o, wid = __builtin_amdgcn_readfirstlane(tid >> 6), lane = tid & 63, r32 = lane & 31, hi = lane >> 5;
    const int sr = tid >> 4, sc = (tid & 15) * 8, kws = KSWZ(sr, sc * 2); char* K_lds = lds + NVS * SHM_V;
    for (int d0 = 0; d0 < 8; ++d0) S.qr[d0] = load8nt(cur.Q + (size_t)(wid * QBLK + r32) * D + d0 * 16 + hi * 8);
    SLOAD_H(cur.K, cur.V, 0); VMW(); SWRITE_HK(0);
    __syncthreads();
}
__device__ __forceinline__ unsigned moba_select(const BlockRef& cur, char* lds, const Seam& S) {
    int tid_o = threadIdx.x; asm volatile("" : "+v"(tid_o));
    const int tid = tid_o, lane = tid & 63, hi = lane >> 5;
    const int own = cur.P0 >> 8;
    float* km = (float*)(lds + LDS_KM);
    __syncthreads();
    *(f32x4*)(km + tid * 4) = *(const f32x4*)(cur.KM + tid * 4);
    __syncthreads();
    float v1 = -__builtin_inff(), v2 = v1, v3 = v1; int i1 = 31, i2 = 31, i3 = 31;
    for (int j = 0; j < own; ++j) {
        const float* kr = km + j * 128 + hi * 8; float a = 0.f;
#pragma unroll
        for (int d0 = 0; d0 < 8; ++d0) { const f32x4 k0 = *(const f32x4*)(kr + d0 * 16), k1 = *(const f32x4*)(kr + d0 * 16 + 4); const bf16x8 q = S.qr[d0];
#pragma unroll
            for (int e = 0; e < 4; ++e) { a = fmaf(__uint_as_float((unsigned)(unsigned short)q[e] << 16), k0[e], a); a = fmaf(__uint_as_float((unsigned)(unsigned short)q[4 + e] << 16), k1[e], a); } }
        const float t = a + __shfl_xor(a, 32);
        if (t > v1) { v3 = v2; i3 = i2; v2 = v1; i2 = i1; v1 = t; i1 = j; }
        else if (t > v2) { v3 = v2; i3 = i2; v2 = t; i2 = j; }
        else if (t > v3) { v3 = t; i3 = j; }
    }
    return ((1u << i1) | (1u << i2) | (1u << i3)) & 0xffffu;
}
__device__ __forceinline__ void moba_block(const BlockRef& cur, const BlockRef& nxt, unsigned sel, char* lds, Seam& S) {
    int tid_o = threadIdx.x; asm volatile("" : "+v"(tid_o));
    const int tid = tid_o, wid = __builtin_amdgcn_readfirstlane(tid >> 6), lane = tid & 63, r32 = lane & 31, hi = lane >> 5;
    const int NT = cur.P0 / KVBLK + 4;
    const int qlo = cur.P0 + wid * QBLK, qm = qlo + r32 - 4 * hi;
    char* V_lds = lds; char* K_lds = lds + NVS * SHM_V;
    float* ws = (float*)(lds + LDS_WS) + wid * 64; float* li_l = ws, * al_l = ws + 32;
    float l_reg = 0, negm = 0.f; f32x16 o[4] = {};
    const int sr = tid >> 4, sc = (tid & 15) * 8, vst0 = v_st(sr, sc), vst1 = v_st(32 + sr, sc), kws = KSWZ(sr, sc * 2);
    const int vb0 = (int)(uintptr_t)V_lds + v_rd_base(lane);
    const bf16* Kh = cur.K; const bf16* Vh = cur.V;
#define RESC(a) do { if (__any((a) < 1.f)) { if (hi == 0) al_l[r32] = (a); asm volatile("s_waitcnt lgkmcnt(0)" ::: "memory");              \
                     for (int d_ = 0; d_ < 4; ++d_) for (int r = 0; r < 16; ++r) o[d_][r] *= al_l[crow(r, hi)]; } } while (0)
#define KBASE(t) ((t) * KVBLK)
#define TINIT(t) ((KBASE(t) < cur.P0 && ((sel >> (KBASE(t) >> 8)) & 1u) == 0u) ? -__builtin_inff() : negm)
#define MASKT(P0_, P1_, t) do { const int kb_ = KBASE(t); if (kb_ >= cur.P0 && kb_ + KVBLK - 1 > qlo) mask_tile(P0_, P1_, qm - kb_); } while (0)
    constexpr int NQL = 8;
#define SEAM_K0() do { VMWN(NQL); SWRITE_HK(0); SBAR(); } while (0)
    f32x16 pA0, pA1, pB0, pB1; bf16x8 pa0, pa1, pa2, pa3;
    SWRITE_HV(0); SBAR();
    SLOAD_H(Kh, Vh, KBASE(1));
    SBAR(); qkt<0>(pA0, pA1, K_lds, r32, hi, S.qr, TINIT(0));
    MASKT(pA0, pA1, 0); { float al0_; partialSM(pA0, pA1, negm, l_reg, al0_); }
    VMW(); SWRITE_H(1);
    __syncthreads();
#define HALF_STEP(PX0, PX1, PY0, PY1, t, KB, SB) do { float alX;                                                    \
        if ((t) + 1 < NT) { SBAR(); SLOAD_H(Kh, Vh, KBASE((t) + 1)); }     \
        SBAR(); qkt<KB>(PX0, PX1, K_lds, r32, hi, S.qr, TINIT(t));                                             \
        finishSM(PY0, PY1, l_reg, pa0, pa1, pa2, pa3); SBAR();                                                           \
        pv_tile<0>(o, vb0 + vs * SHM_V, pa0, pa1, pa2, pa3); MASKT(PX0, PX1, (t)); partialSM(PX0, PX1, negm, l_reg, alX);                                        \
        if ((t) + 1 < NT) { VMW(); SWRITE_HK(SB); SWRITE_HV(vs == 0 ? 2 : vs - 1); }     \
        RESC(alX); vs = vs == 2 ? 0 : vs + 1; __syncthreads(); } while (0)
    int vs = 0;
    for (int t = 1; t + 1 < NT; t += 2) {
        HALF_STEP(pB0, pB1, pA0, pA1, t, 1, 0);
        HALF_STEP(pA0, pA1, pB0, pB1, t + 1, 0, 1);
    }
    { SBAR(); qkt<1>(pB0, pB1, K_lds, r32, hi, S.qr, TINIT(NT - 1)); SBAR(); }
    SLOAD_H(nxt.K, nxt.V, 0); SBAR();
#pragma unroll
    for (int d0 = 0; d0 < 8; ++d0) S.qr[d0] = load8nt(nxt.Q + (size_t)(wid * QBLK + r32) * D + d0 * 16 + hi * 8);
    SBAR();
    finishSM(pA0, pA1, l_reg, pa0, pa1, pa2, pa3); SBAR();
    pv_tile<0>(o, vb0 + vs * SHM_V, pa0, pa1, pa2, pa3);
    { float alB; MASKT(pB0, pB1, NT - 1); partialSM(pB0, pB1, negm, l_reg, alB); __syncthreads(); RESC(alB);
      finishSM(pB0, pB1, l_reg, pa0, pa1, pa2, pa3); SBAR(); pv_tile<0>(o, vb0 + (vs == 2 ? 0 : vs + 1) * SHM_V, pa0, pa1, pa2, pa3); }
    SBAR(); SEAM_K0();
    if (hi == 0) li_l[r32] = l_reg; asm volatile("s_waitcnt lgkmcnt(0)" ::: "memory");
    float rli[16];
#pragma unroll
    for (int r = 0; r < 16; ++r) rli[r] = __builtin_amdgcn_rcpf(li_l[crow(r, hi)]);
    char* Ow = (char*)(cur.O + (size_t)(wid * QBLK) * OPITCH);
    unsigned obase = (unsigned)(hi * 4 * OPITCH + r32); asm volatile("" : "+v"(obase));
#pragma unroll
    for (int r = 0; r < 16; ++r) { const int orow = crow(r, hi); float ss = 0.f; const unsigned off = obase + (unsigned)(((r & 3) + 8 * (r >> 2)) * OPITCH);
#pragma unroll
        for (int d0 = 0; d0 < 4; ++d0) { const float v = o[d0][r] * rli[r]; ss = fmaf(v, v, ss);
            const float v16 = __builtin_amdgcn_fmed3f(v * 16.0f, -448.0f, 448.0f); const unsigned bq = (unsigned)__builtin_amdgcn_cvt_pk_fp8_f32(v16, v16, 0, false) & 0xffu;
            const unsigned x1 = __shfl_xor(bq, 1), x2 = __shfl_xor(bq, 2), x3 = __shfl_xor(x1, 2);
            if ((r32 & 3) == 0) *(unsigned*)(Ow + off + d0 * 32) = bq | (x1 << 8) | (x2 << 16) | (x3 << 24); }
        ss += __shfl_xor(ss, 1); ss += __shfl_xor(ss, 2); ss += __shfl_xor(ss, 4); ss += __shfl_xor(ss, 8); ss += __shfl_xor(ss, 16);
        if (r32 == 0) cur.SS[wid * QBLK + orow] = ss; }
    __syncthreads();
#undef RESC
#undef KBASE
#undef MASKT
#undef TINIT
#undef SEAM_K0
#undef HALF_STEP
}

constexpr int T_V = 0, T_K = 3 * SHM_V, T_WS = T_K + 3 * 16384, T_KM = T_WS + NW * 64 * 4, T_BYTES = T_KM + 16 * 128 * 4;
typedef __attribute__((address_space(3))) unsigned char lds_u8;
typedef __attribute__((address_space(3))) unsigned lds_u32;
__device__ __forceinline__ void moba_block_t16(const BlockRef& cur, char* lds, lds_u8* ldsl) {
    int tid_o = threadIdx.x; asm volatile("" : "+v"(tid_o));
    const int tid = tid_o, wid = __builtin_amdgcn_readfirstlane(tid >> 6), lane = tid & 63, r32 = lane & 31, hi = lane >> 5;
    const int NT = cur.P0 / KVBLK + 4;
    const int qlo = cur.P0 + wid * QBLK, qm = qlo + r32 - 4 * hi;
    float* ws = (float*)(lds + T_WS) + wid * 64; float* li_l = ws, * al_l = ws + 32;
    const bf16* Kh = cur.K; const bf16* Vh = cur.V;
    unsigned koff[2], voff[2];
#pragma unroll
    for (int i = 0; i < 2; ++i) { const int q = 2 * wid + i, kr = 4 * q + (lane >> 4), kc = (lane & 15) ^ (kr & 15); koff[i] = (unsigned)(kr * D + kc * 8);
        const int s_ = 2 * q + (lane >> 5); voff[i] = (unsigned)((8 * (s_ >> 2) + ((lane & 31) >> 2)) * D + 32 * (s_ & 3) + 8 * (lane & 3)); }
#define DMA_K(t_, slot_) do { _Pragma("unroll") for (int i_ = 0; i_ < 2; ++i_) __builtin_amdgcn_global_load_lds((const unsigned*)(Kh + (size_t)(t_) * (KVBLK * D) + koff[i_]), (lds_u32*)(ldsl + T_K + (slot_) * 16384 + (2 * wid + i_) * 1024), 16, 0, 0); } while (0)
#define DMA_V(t_, slot_) do { _Pragma("unroll") for (int i_ = 0; i_ < 2; ++i_) __builtin_amdgcn_global_load_lds((const unsigned*)(Vh + (size_t)(t_) * (KVBLK * D) + voff[i_]), (lds_u32*)(ldsl + T_V + (slot_) * SHM_V + (2 * wid + i_) * 1024), 16, 0, 0); } while (0)
    DMA_K(0, 0); DMA_V(0, 0); DMA_K(1, 1); DMA_V(1, 1);
    bf16x8 qr[8];
#pragma unroll
    for (int d0 = 0; d0 < 8; ++d0) qr[d0] = load8nt(cur.Q + (size_t)(wid * QBLK + r32) * D + d0 * 16 + hi * 8);
    unsigned sel;
    { const int own = cur.P0 >> 8; float* km = (float*)(lds + T_KM);
      *(f32x4*)(km + tid * 4) = *(const f32x4*)(cur.KM + tid * 4);
      asm volatile("s_waitcnt vmcnt(0)" ::: "memory");
      __syncthreads();
      float v1 = -__builtin_inff(), v2 = v1, v3 = v1; int i1 = 31, i2 = 31, i3 = 31;
      for (int j = 0; j < own; ++j) {
          const float* kr = km + j * 128 + hi * 8; float a = 0.f;
#pragma unroll
          for (int d0 = 0; d0 < 8; ++d0) { const f32x4 k0 = *(const f32x4*)(kr + d0 * 16), k1 = *(const f32x4*)(kr + d0 * 16 + 4); const bf16x8 q = qr[d0];
#pragma unroll
              for (int e = 0; e < 4; ++e) { a = fmaf(__uint_as_float((unsigned)(unsigned short)q[e] << 16), k0[e], a); a = fmaf(__uint_as_float((unsigned)(unsigned short)q[4 + e] << 16), k1[e], a); } }
          const float t = a + __shfl_xor(a, 32);
          if (t > v1) { v3 = v2; i3 = i2; v2 = v1; i2 = i1; v1 = t; i1 = j; }
          else if (t > v2) { v3 = v2; i3 = i2; v2 = t; i2 = j; }
          else if (t > v3) { v3 = t; i3 = j; }
      }
      sel = ((1u << i1) | (1u << i2) | (1u << i3)) & 0xffffu; }
    float l_reg = 0, negm = 0.f; f32x16 o[4] = {};
    const unsigned kx = (unsigned)(uintptr_t)(lds + T_K) + (unsigned)(r32 * 256) + (unsigned)(((r32 & 15) ^ hi) << 4);
    const int vb0 = (int)(uintptr_t)(lds + T_V) + v_rd_base(lane);
#define RESC(a) do { if (__any((a) < 1.f)) { if (hi == 0) al_l[r32] = (a); asm volatile("s_waitcnt lgkmcnt(0)" ::: "memory");              \
                     for (int d_ = 0; d_ < 4; ++d_) for (int r = 0; r < 16; ++r) o[d_][r] *= al_l[crow(r, hi)]; } } while (0)
#define KBASE(t) ((t) * KVBLK)
#define CBAR() do { SBAR(); asm volatile("s_waitcnt lgkmcnt(0)" ::: "memory"); __builtin_amdgcn_s_barrier(); asm volatile("" ::: "memory"); SBAR(); } while (0)
    typedef __attribute__((address_space(3))) const bf16x8 lds_b8;
    int ks = 0;
    if (wid >= 4) CBAR();
    for (int t = 0; t < NT; ++t) {
        const int k2 = ks == 0 ? 2 : ks - 1;
        bf16x8 kf0[8], kf1[8];
        { const unsigned kb = kx + (unsigned)(ks * 16384);
#pragma unroll
          for (int d0 = 0; d0 < 8; ++d0) { const unsigned a = kb ^ (unsigned)(d0 << 5); kf0[d0] = *(lds_b8*)(a); kf1[d0] = *(lds_b8*)(a + 32 * 256); } }
        CBAR();
        f32x16 p0, p1;
        { const int kb_ = KBASE(t); const float init = (kb_ < cur.P0 && ((sel >> (kb_ >> 8)) & 1u) == 0u) ? -__builtin_inff() : negm;
#pragma unroll
          for (int r = 0; r < 16; ++r) { p0[r] = init; p1[r] = init; }
#pragma unroll
          for (int d0 = 0; d0 < 8; ++d0) { p0 = __builtin_amdgcn_mfma_f32_32x32x16_bf16(kf0[d0], qr[d0], p0, 0, 0, 0); p1 = __builtin_amdgcn_mfma_f32_32x32x16_bf16(kf1[d0], qr[d0], p1, 0, 0, 0); } }
        SBAR();
        if (t + 2 < NT) { DMA_K(t + 2, k2); DMA_V(t + 2, k2); asm volatile("s_waitcnt vmcnt(4)" ::: "memory"); } else asm volatile("s_waitcnt vmcnt(0)" ::: "memory");
        CBAR();
        s16x4 vl[4][4], vh[4][4];
        { const int vbs = vb0 + ks * SHM_V;
#define TRRD(dst, off) asm volatile("ds_read_b64_tr_b16 %0, %1 offset:%2" : "=&v"(dst) : "v"(vbs), "i"(off) : "memory")
#define TR4(s_) do { TRRD(vl[s_][0], v_rd_off(0, s_, 0)); TRRD(vh[s_][0], v_rd_off(0, s_, 1)); TRRD(vl[s_][1], v_rd_off(1, s_, 0)); TRRD(vh[s_][1], v_rd_off(1, s_, 1)); \
                     TRRD(vl[s_][2], v_rd_off(2, s_, 0)); TRRD(vh[s_][2], v_rd_off(2, s_, 1)); TRRD(vl[s_][3], v_rd_off(3, s_, 0)); TRRD(vh[s_][3], v_rd_off(3, s_, 1)); } while (0)
          TR4(0); TR4(1); TR4(2); TR4(3);
#undef TR4
#undef TRRD
        }
        bf16x8 pa0, pa1, pa2, pa3; float al;
        { const int kb_ = KBASE(t); if (kb_ >= cur.P0 && kb_ + KVBLK - 1 > qlo) mask_tile(p0, p1, qm - kb_); }
        partialSM(p0, p1, negm, l_reg, al);
        RESC(al);
#define PK4(P, B_, OUT) do { u32x4 w = {cvtpk(P[B_+0], P[B_+1]), cvtpk(P[B_+2], P[B_+3]), cvtpk(P[B_+4], P[B_+5]), cvtpk(P[B_+6], P[B_+7])}; OUT = *reinterpret_cast<bf16x8*>(&w); } while (0)
        PK4(p0, 0, pa0); PK4(p0, 8, pa1);
        CBAR();
#define PVM(s_, pa) do { _Pragma("unroll") for (int d0 = 0; d0 < 4; ++d0) \
            o[d0] = __builtin_amdgcn_mfma_f32_32x32x16_bf16(pa, (bf16x8){vl[s_][d0][0], vl[s_][d0][1], vl[s_][d0][2], vl[s_][d0][3], vh[s_][d0][0], vh[s_][d0][1], vh[s_][d0][2], vh[s_][d0][3]}, o[d0], 0, 0, 0); } while (0)
        PVM(0, pa0); PVM(1, pa1); SBAR();
        { for (int r = 0; r < 16; ++r) p1[r] = __builtin_amdgcn_exp2f(p1[r]);
          f32x2 s2 = {p0[0], p0[1]};
          for (int i = 1; i < 8; ++i) s2 += (f32x2){p0[2 * i], p0[2 * i + 1]};
          for (int i = 0; i < 8; ++i) s2 += (f32x2){p1[2 * i], p1[2 * i + 1]};
          float ps = s2[0] + s2[1];
          { auto rr = __builtin_amdgcn_permlane32_swap(__float_as_uint(ps), __float_as_uint(ps), false, false); ps = __uint_as_float(rr[0]) + __uint_as_float(rr[1]); }
          l_reg += ps;
          PK4(p1, 0, pa2); PK4(p1, 8, pa3); }
        SBAR();
        PVM(2, pa2); PVM(3, pa3);
#undef PK4
#undef PVM
        CBAR();
        ks = ks == 2 ? 0 : ks + 1;
    }
    if (wid < 4) CBAR();
    if (hi == 0) li_l[r32] = l_reg; asm volatile("s_waitcnt lgkmcnt(0)" ::: "memory");
    float rli[16];
#pragma unroll
    for (int r = 0; r < 16; ++r) rli[r] = __builtin_amdgcn_rcpf(li_l[crow(r, hi)]);
    char* Ow = (char*)(cur.O + (size_t)(wid * QBLK) * OPITCH);
    unsigned obase = (unsigned)(hi * 4 * OPITCH + r32); asm volatile("" : "+v"(obase));
#pragma unroll
    for (int r = 0; r < 16; ++r) { const int orow = crow(r, hi); float ss = 0.f; const unsigned off = obase + (unsigned)(((r & 3) + 8 * (r >> 2)) * OPITCH);
#pragma unroll
        for (int d0 = 0; d0 < 4; ++d0) { const float v = o[d0][r] * rli[r]; ss = fmaf(v, v, ss);
            const float v16 = __builtin_amdgcn_fmed3f(v * 16.0f, -448.0f, 448.0f); const unsigned bq = (unsigned)__builtin_amdgcn_cvt_pk_fp8_f32(v16, v16, 0, false) & 0xffu;
            const unsigned x1 = __shfl_xor(bq, 1), x2 = __shfl_xor(bq, 2), x3 = __shfl_xor(x1, 2);
            if ((r32 & 3) == 0) *(unsigned*)(Ow + off + d0 * 32) = bq | (x1 << 8) | (x2 << 16) | (x3 << 24); }
        ss += __shfl_xor(ss, 1); ss += __shfl_xor(ss, 2); ss += __shfl_xor(ss, 4); ss += __shfl_xor(ss, 8); ss += __shfl_xor(ss, 16);
        if (r32 == 0) cur.SS[wid * QBLK + orow] = ss; }
    __syncthreads();
#undef RESC
#undef KBASE
#undef CBAR
#undef DMA_K
#undef DMA_V
}
#undef ROW
#undef VMW
#undef VMWN
#undef SLOAD_H
#undef SWRITE_HK
#undef SWRITE_HV
#undef SWRITE_H
#undef KSWZ
#undef SBAR
}

constexpr int NWAVES = 8;
#ifndef MK_N_LAUNCHES
#define MK_N_LAUNCHES 1
#endif
constexpr int N_PHASES = 11;
constexpr int N_LAUNCHES = MK_N_LAUNCHES;
static_assert(N_LAUNCHES == 1 || N_LAUNCHES == N_PHASES, "MK_N_LAUNCHES is 1 or 11");

constexpr int BATCH = 4, SEQ = 4096, DM = 2048, M = BATCH * SEQ;
constexpr int NH = 8, HD = 128, AW = 1024, RW = 1024, NRB = 16, RBD = 64;
constexpr int INC = 5120, DFF = 5504, NGU = 2 * DFF;
constexpr float EPS = 1e-6f;

constexpr size_t MiB = 1u << 20;
constexpr size_t WS_CTL = 0, CTL_ZERO_BYTES = 64 * 1024;
constexpr size_t WS_KMEAN = 512 * 1024;
constexpr size_t WS_ROPE = 1 * MiB;
constexpr size_t WS_SSA = 2 * MiB;
constexpr size_t WS_SSR = 3 * MiB;
constexpr int P0_GU2 = 264;
constexpr int DFFP = 5632;
constexpr size_t WS_SC = 7 * MiB;
constexpr size_t WS_WGU1 = 8 * MiB;
constexpr size_t WS_WD1 = 51 * MiB;
constexpr size_t WS_WIN = 73 * MiB;
constexpr size_t WS_WOUT = 93 * MiB;
constexpr size_t WS_WGU2 = 101 * MiB;
constexpr size_t WS_WD2 = 123 * MiB;
constexpr size_t WS_H = 134 * MiB;
constexpr size_t WS_ACT = 198 * MiB;
constexpr size_t WS_CG = 370 * MiB;
constexpr size_t WS_OL = 402 * MiB;
constexpr size_t WS_END = 434 * MiB;
static_assert(true, "");
constexpr size_t ACT_Q = 0, ACT_K = 32 * MiB, ACT_V = 64 * MiB, ACT_XR = 96 * MiB, ACT_GR = 128 * MiB;
static_assert(WS_WGU1 + (size_t)M * DM * 2 <= WS_WIN, "residual overlay");
static_assert(WS_WGU1 + (size_t)NGU * DM * 2 <= WS_WD1 && WS_WD1 + (size_t)DM * DFF * 2 <= WS_WIN && WS_WIN + (size_t)INC * DM * 2 <= WS_WOUT && WS_WOUT + (size_t)DM * DM * 2 <= WS_WGU2 &&
              WS_WGU2 + (size_t)NGU * DM <= WS_WD2 && WS_WD2 + (size_t)DM * DFFP <= WS_H && WS_H + (size_t)M * DM * 2 <= WS_ACT && WS_ACT + (size_t)M * DFF * 2 <= WS_END && 5 * 32 * MiB <= (size_t)M * DFF * 2 && (size_t)M * DFFP <= (size_t)M * DFF * 2, "d_ws map");
constexpr int CW_TMO = 0, CW_CODE = 1, CW_BAR = 4096;

constexpr int RING_OFF = 0, RING_BYTES = 131072;
constexpr int LDSCTL_OFF = RING_BYTES, MISC_OFF = LDSCTL_OFF + 320, SCL_OFF = LDSCTL_OFF + 1024;
constexpr int LDS_BYTES = 147456;
static_assert(SCL_OFF + 8192 <= LDS_BYTES && moba::LDS_BYTES <= RING_BYTES && moba::T_BYTES <= RING_BYTES, "LDS map");

#define GAS __attribute__((address_space(1)))
#define LAS __attribute__((address_space(3)))
typedef unsigned short bf16;
typedef unsigned v4u __attribute__((ext_vector_type(4)));
typedef float f32x4 __attribute__((ext_vector_type(4)));
typedef short bf16x8 __attribute__((ext_vector_type(8)));
typedef GAS unsigned gu32;
typedef GAS unsigned long long gu64;
#define RLX_AGENT __ATOMIC_RELAXED, __HIP_MEMORY_SCOPE_AGENT
#define LDS_WAIT() asm volatile("s_waitcnt lgkmcnt(0)" ::: "memory")
#define VM_WAIT() asm volatile("s_waitcnt vmcnt(0)" ::: "memory")
__device__ __forceinline__ unsigned long long rt() { return __builtin_amdgcn_s_memrealtime(); }
__device__ __forceinline__ unsigned f2bf(float f) { unsigned u = __builtin_bit_cast(unsigned, f); return (u + 0x7fffu + ((u >> 16) & 1u)) >> 16; }
__device__ __forceinline__ unsigned pk2(float lo, float hi) { return f2bf(lo) | (f2bf(hi) << 16); }

#define XB_TMO      128
#define XB_XCNT(j)  (256  + 64 * (j))
#define XB_XSUB(j)  (1280 + 64 * (j))
#define XB_XGEN(j)  (2304 + 64 * (j))
#define XB_TOP      3328
#define XB_TOPGEN   3392
#define XCD_BAR_WORDS 3456
#define XB_SPIN_CAP (1u << 18)

__device__ __forceinline__ unsigned xb_ld(unsigned* p)              { return __hip_atomic_load(p, __ATOMIC_RELAXED, __HIP_MEMORY_SCOPE_AGENT); }
__device__ __forceinline__ unsigned xb_add(unsigned* p, unsigned v) { return __hip_atomic_fetch_add(p, v, __ATOMIC_RELAXED, __HIP_MEMORY_SCOPE_AGENT); }
__device__ __forceinline__ unsigned xb_xcc_id() { return (unsigned)__builtin_amdgcn_s_getreg((3 << 11) | 20) & 0xFu; }
#define XB_SPIN(cond, bar) do { unsigned _sp = 0; while (cond) { __builtin_amdgcn_s_sleep(1); \
    if ((++_sp & 255u) == 0u) { if (xb_ld(&(bar)[XB_TMO])) break; if (_sp > XB_SPIN_CAP) { atomicAdd(&(bar)[XB_TMO], 1u); break; } } } } while (0)

struct XcdBarrier {
    unsigned* bar; unsigned x;
    volatile LAS unsigned* st;
};

__device__ __forceinline__ XcdBarrier xcd_barrier_post(unsigned* bar, volatile LAS unsigned* st) {
    XcdBarrier b; b.bar = bar; b.x = xb_xcc_id(); b.st = st;
    if (threadIdx.x == 0) (void)xb_add(&bar[XB_XCNT(b.x)], 1u);
    return b;
}
__device__ __forceinline__ void xcd_barrier_complete(unsigned* bar, unsigned x, unsigned& nloc, unsigned& nx) {
    const unsigned G = gridDim.x * gridDim.y * gridDim.z;
    unsigned sum, cnt, mine, sp = 0u;
    for (;;) {
        sum = 0u; cnt = 0u; mine = 0u;
#pragma unroll
        for (unsigned j = 0; j < 16; ++j) { const unsigned c = xb_ld(&bar[XB_XCNT(j)]); sum += c; cnt += (c > 0u) ? 1u : 0u; mine = (j == x) ? c : mine; }
        if (sum == G) break;
        __builtin_amdgcn_s_sleep(1);
        if ((++sp & 255u) == 0u) { if (xb_ld(&bar[XB_TMO])) break; if (sp > XB_SPIN_CAP) { atomicAdd(&bar[XB_TMO], 1u); break; } }
    }
    nloc = mine > 0u ? mine : 1u; nx = cnt > 0u ? cnt : 1u;
}

__device__ __forceinline__ void xcd_barrier(const XcdBarrier& b) {
    asm volatile("s_waitcnt vmcnt(0)" ::: "memory");
    __syncthreads();
    if (threadIdx.x == 0) {
        unsigned* bar = b.bar;
        __builtin_amdgcn_s_waitcnt(0);
        unsigned nloc = b.st[0], nx = b.st[1];
        if (nloc == 0u) { xcd_barrier_complete(bar, b.x, nloc, nx); b.st[0] = nloc; b.st[1] = nx; }
        const unsigned old = xb_add(&bar[XB_XSUB(b.x)], 1u);
        const unsigned gen = old / nloc;
        if (old + 1u == (gen + 1u) * nloc) {
            __builtin_amdgcn_fence(__ATOMIC_RELEASE, "agent");
            asm volatile("s_waitcnt vmcnt(0)" ::: "memory");
            const unsigned og = xb_add(&bar[XB_TOP], 1u);
            const unsigned tg = og / nx;
            if (og + 1u == (tg + 1u) * nx) xb_add(&bar[XB_TOPGEN], 1u);
            else XB_SPIN(xb_ld(&bar[XB_TOPGEN]) == tg, bar);
            __builtin_amdgcn_fence(__ATOMIC_ACQUIRE, "agent");
            xb_add(&bar[XB_XGEN(b.x)], 1u);
            asm volatile("s_waitcnt vmcnt(0)" ::: "memory");
        } else {
            XB_SPIN(xb_ld(&bar[XB_XGEN(b.x)]) == gen, bar);
            __builtin_amdgcn_fence(__ATOMIC_ACQUIRE, "agent");
            asm volatile("s_waitcnt vmcnt(0)" ::: "memory");
        }
    }
    __syncthreads();
}

struct Frame {
    LAS unsigned char* lds;
    volatile LAS unsigned* MISC;
    gu32* ctl;
    int vcu, G;
};
__device__ __forceinline__ float wave_sum(float v) {
#pragma unroll
    for (int o = 1; o < 64; o <<= 1) v += __shfl_xor(v, o);
    return v;
}
__device__ __forceinline__ float wave_max(float v) {
#pragma unroll
    for (int o = 1; o < 64; o <<= 1) v = fmaxf(v, __shfl_xor(v, o));
    return v;
}
__device__ __forceinline__ unsigned pack_i8x4(f32x4 v) {
    const int a = (int)__builtin_rintf(v.x), b = (int)__builtin_rintf(v.y), c = (int)__builtin_rintf(v.z), d = (int)__builtin_rintf(v.w);
    return (unsigned)(a & 0xff) | ((unsigned)(b & 0xff) << 8) | ((unsigned)(c & 0xff) << 16) | ((unsigned)d << 24);
}
__device__ __forceinline__ float amax4(f32x4 v) { return fmaxf(fmaxf(fabsf(v.x), fabsf(v.y)), fmaxf(fabsf(v.z), fabsf(v.w))); }
__device__ __forceinline__ float bf2f(unsigned short b) { return __uint_as_float((unsigned)b << 16); }
__device__ __forceinline__ void transpose_item(const float* W, int N, int Kd, bf16* WT, int k0, int n0, int drow0, const float* ksc, LAS float* scr, int lane, bool nts) {
    { f32x4 v[8];
#pragma unroll
      for (int i = 0; i < 8; ++i) v[i] = __builtin_nontemporal_load((const f32x4*)(W + (size_t)(k0 + 8 * i + (lane >> 3)) * N + n0 + 4 * (lane & 7)));
#pragma unroll
      for (int i = 0; i < 8; ++i) { const int kk = 8 * i + (lane >> 3); f32x4 t = v[i]; if (ksc) t = t * ksc[k0 + kk]; LAS float* d = scr + kk * 33 + 4 * (lane & 7); d[0] = t.x; d[1] = t.y; d[2] = t.z; d[3] = t.w; } }
    LDS_WAIT(); asm volatile("" ::: "memory");
    const int c = lane & 7;
#pragma unroll
    for (int j = 0; j < 4; ++j) { const int n = (lane >> 3) + 8 * j; const LAS float* s = scr + (8 * c) * 33 + n;
        v4u o; o.x = pk2(s[0 * 33], s[1 * 33]); o.y = pk2(s[2 * 33], s[3 * 33]); o.z = pk2(s[4 * 33], s[5 * 33]); o.w = pk2(s[6 * 33], s[7 * 33]);
        v4u* dp = (v4u*)(WT + (size_t)(drow0 + n) * Kd + k0 + 8 * c); if (nts) __builtin_nontemporal_store(o, dp); else *dp = o; }
    LDS_WAIT(); asm volatile("" ::: "memory");
}
__device__ __forceinline__ void transpose_item_f8(const float* W, int N, int Kd, unsigned char* WT, int k0, int n0, int drow0, float sc, const float* ksc, LAS float* scr, int lane, bool nts) {
    { f32x4 v[8];
#pragma unroll
      for (int i = 0; i < 8; ++i) v[i] = __builtin_nontemporal_load((const f32x4*)(W + (size_t)(k0 + 8 * i + (lane >> 3)) * N + n0 + 4 * (lane & 7)));
#pragma unroll
      for (int i = 0; i < 8; ++i) { const int kk = 8 * i + (lane >> 3); f32x4 t = v[i] * sc; if (ksc) t = t * ksc[k0 + kk]; LAS float* d = scr + kk * 33 + 4 * (lane & 7); d[0] = t.x; d[1] = t.y; d[2] = t.z; d[3] = t.w; } }
    LDS_WAIT(); asm volatile("" ::: "memory");
    const int c = lane & 7;
#pragma unroll
    for (int j = 0; j < 4; ++j) { const int n = (lane >> 3) + 8 * j; const LAS float* s = scr + (8 * c) * 33 + n;
        typedef unsigned u32x2v __attribute__((ext_vector_type(2)));
        u32x2v o; o.x = pg8::cvt4_fp8(s[0 * 33], s[1 * 33], s[2 * 33], s[3 * 33]); o.y = pg8::cvt4_fp8(s[4 * 33], s[5 * 33], s[6 * 33], s[7 * 33]);
        u32x2v* dp = (u32x2v*)(WT + (size_t)(drow0 + n) * Kd + k0 + 8 * c); if (nts) __builtin_nontemporal_store(o, dp); else *dp = o; }
    LDS_WAIT(); asm volatile("" ::: "memory");
}
__device__ __forceinline__ void transpose_matrix_f8(Frame& F, const float* W, int K, int N, int NC, unsigned char* WT, int Kd, float sc, const float* ksc, bool gu, LAS float* scr, int gw0, int NGW, bool nts = false) {
    const int nblk = NC / 32, nitems = (K / 64) * nblk;
    for (int it = gw0; it < nitems; it += NGW) { const int kb = it / nblk, nb = it - kb * nblk, n0 = 32 * nb; int drow0 = n0;
        if (gu) { const int half = n0 >= DFF, nn = n0 - half * DFF; drow0 = 256 * (nn >> 7) + 128 * half + (nn & 127); }
        transpose_item_f8(W, N, Kd, WT, 64 * kb, n0, drow0, sc, ksc, scr, ((int)threadIdx.x & 63), nts); }
}
__device__ __forceinline__ void transpose_matrix(Frame& F, const float* W, int K, int N, int NC, bf16* WT, int Kd, const float* ksc, bool gu, LAS float* scr, int gw0, int NGW, bool nts = false) {
    const int nblk = NC / 32, nitems = (K / 64) * nblk;
    for (int it = gw0; it < nitems; it += NGW) { const int kb = it / nblk, nb = it - kb * nblk, n0 = 32 * nb; int drow0 = n0;
        if (gu) { const int half = n0 >= DFF, nn = n0 - half * DFF; drow0 = 256 * (nn >> 7) + 128 * half + (nn & 127); }
        transpose_item(W, N, Kd, WT, 64 * kb, n0, drow0, ksc, scr, ((int)threadIdx.x & 63), nts); }
}
__device__ __forceinline__ void quant_strips_i8(Frame& F, const float* W, int N, unsigned char* WT, float* sw, bool gu, int s_first, int s_end, int stride, bool nts = false) {
    const int lane = (int)threadIdx.x & 63, wave = __builtin_amdgcn_readfirstlane((int)threadIdx.x >> 6), c8 = lane & 7, r8 = lane >> 3;
    LAS float* scr = (LAS float*)(F.lds + RING_OFF + wave * 16384); LAS float* mx = (LAS float*)(F.lds + RING_OFF + 12288);
    for (int it = s_first; it < s_end; it += stride) {
        const int n0 = 32 * it; int drow0 = n0;
        if (gu) { const int half = n0 >= DFF, nn = n0 - half * DFF; drow0 = 256 * (nn >> 7) + 128 * half + (nn & 127); }
        f32x4 v[4][8]; f32x4 m4 = {0.f, 0.f, 0.f, 0.f};
#pragma unroll
        for (int sb = 0; sb < 4; ++sb)
#pragma unroll
            for (int i = 0; i < 8; ++i) v[sb][i] = __builtin_nontemporal_load((const f32x4*)(W + (size_t)(256 * wave + 64 * sb + 8 * i + r8) * N + n0 + 4 * c8));
#pragma unroll
        for (int sb = 0; sb < 4; ++sb)
#pragma unroll
            for (int i = 0; i < 8; ++i) m4 = __builtin_elementwise_max(m4, __builtin_elementwise_abs(v[sb][i]));
#pragma unroll
        for (int j = 0; j < 4; ++j) { float t = m4[j]; t = fmaxf(t, __shfl_xor(t, 8)); t = fmaxf(t, __shfl_xor(t, 16)); t = fmaxf(t, __shfl_xor(t, 32)); m4[j] = t; }
        if (r8 == 0) *(LAS f32x4*)(mx + wave * 4096 + 4 * c8) = m4;
        __syncthreads();
        f32x4 am = *(const LAS f32x4*)(mx + 4 * c8);
#pragma unroll
        for (int w2 = 1; w2 < 8; ++w2) am = __builtin_elementwise_max(am, *(const LAS f32x4*)(mx + w2 * 4096 + 4 * c8));
        f32x4 sc;
#pragma unroll
        for (int j = 0; j < 4; ++j) sc[j] = am[j] > 0.f ? 127.0f / am[j] : 0.f;
        if (wave == 0 && r8 == 0) *(f32x4*)(sw + drow0 + 4 * c8) = am * (1.0f / 127.0f);
#pragma unroll
        for (int sb = 0; sb < 4; ++sb) {
#pragma unroll
            for (int i = 0; i < 8; ++i) { const f32x4 t = v[sb][i] * sc; LAS float* d = scr + (8 * i + r8) * 33 + 4 * c8; d[0] = t.x; d[1] = t.y; d[2] = t.z; d[3] = t.w; }
            LDS_WAIT(); asm volatile("" ::: "memory");
#pragma unroll
            for (int j = 0; j < 4; ++j) { const int n = r8 + 8 * j; const LAS float* s = scr + (8 * c8) * 33 + n;
                typedef unsigned u32x2v __attribute__((ext_vector_type(2)));
                u32x2v o; o.x = pack_i8x4((f32x4){s[0 * 33], s[1 * 33], s[2 * 33], s[3 * 33]}); o.y = pack_i8x4((f32x4){s[4 * 33], s[5 * 33], s[6 * 33], s[7 * 33]});
                u32x2v* dp = (u32x2v*)(WT + (size_t)(drow0 + n) * DM + 256 * wave + 64 * sb + 8 * c8); if (nts) __builtin_nontemporal_store(o, dp); else *dp = o; }
            LDS_WAIT(); asm volatile("" ::: "memory");
        }
        __syncthreads();
    }
}
__device__ __forceinline__ void sincos_tab(double a, float& c, float& s) {
    const double k = rint(a * 0.15915494309189535); double r = fma(-k, 6.283185307179586, a); r = fma(-k, 2.4492935982947064e-16, r);
    const double r2 = r * r; double sv = 1.0, cv = 1.0;
#pragma unroll
    for (int n = 14; n >= 1; --n) { sv = 1.0 - r2 * sv * (1.0 / (double)((2 * n) * (2 * n + 1))); cv = 1.0 - r2 * cv * (1.0 / (double)((2 * n - 1) * (2 * n))); }
    s = (float)(r * sv); c = (float)cv;
}
__device__ __forceinline__ void store_row_i8(const f32x4 (&o)[8], unsigned char* hrow8, float* shrow) {
    float am = 0.f;
#pragma unroll
    for (int i = 0; i < 8; ++i) am = fmaxf(am, amax4(o[i]));
    am = wave_max(am);
    const float sc = am > 0.f ? 127.0f / am : 0.f;
#pragma unroll
    for (int i = 0; i < 8; ++i) *(unsigned*)(hrow8 + 256 * i + 4 * ((int)threadIdx.x & 63)) = pack_i8x4(o[i] * sc);
    if (((int)threadIdx.x & 63) == 0) *shrow = am * (1.0f / 127.0f);
}
__device__ __forceinline__ void rms_rows(Frame& F, const float* x, const float* g, unsigned char* hout8, float* sh) {
    const int gw = F.vcu * NWAVES + __builtin_amdgcn_readfirstlane((int)threadIdx.x >> 6), NGW = F.G * NWAVES;
    f32x4 gv[8];
#pragma unroll
    for (int i = 0; i < 8; ++i) gv[i] = *(const f32x4*)(g + 256 * i + 4 * ((int)threadIdx.x & 63));
    for (int m = gw; m < M; m += NGW) {
        const float* xr = x + (size_t)m * DM + 4 * ((int)threadIdx.x & 63); f32x4 v[8]; float s = 0.f;
#pragma unroll
        for (int i = 0; i < 8; ++i) { v[i] = __builtin_nontemporal_load((const f32x4*)(xr + 256 * i)); s += (v[i].x * v[i].x + v[i].y * v[i].y) + (v[i].z * v[i].z + v[i].w * v[i].w); }
        const float rs = 1.0f / sqrtf(wave_sum(s) * (1.0f / DM) + EPS);
#pragma unroll
        for (int i = 0; i < 8; ++i) v[i] = v[i] * rs * gv[i];
        store_row_i8(v, hout8 + (size_t)m * DM, sh + m);
    }
}
template <int HAS_H  , bool BASE_BF16, bool OUT_BF16>
__device__ __forceinline__ void norm_res_rows(Frame& F, const bf16* src, const void* basev, void* outv, void* hout, unsigned char* hout8, float* sh, const float* gpost, const float* gpre, float alpha) {
    const int gw = F.vcu * NWAVES + __builtin_amdgcn_readfirstlane((int)threadIdx.x >> 6), NGW = F.G * NWAVES;
    f32x4 gp[8], gq[8];
#pragma unroll
    for (int i = 0; i < 8; ++i) { gp[i] = *(const f32x4*)(gpost + 256 * i + 4 * ((int)threadIdx.x & 63)) * alpha; if (HAS_H) gq[i] = *(const f32x4*)(gpre + 256 * i + 4 * ((int)threadIdx.x & 63)); }
    for (int m = gw; m < M; m += NGW) {
        const bf16* sr = src + (size_t)m * DM + 4 * ((int)threadIdx.x & 63); const size_t eo = (size_t)m * DM + 4 * ((int)threadIdx.x & 63);
        f32x4 f[8], x[8]; float s = 0.f;
#pragma unroll
        for (int i = 0; i < 8; ++i) { const unsigned long long w = __builtin_nontemporal_load((const unsigned long long*)(sr + 256 * i));
            if (BASE_BF16) { const unsigned long long bw = __builtin_nontemporal_load((const unsigned long long*)((const bf16*)basev + eo + 256 * i));
                x[i] = (f32x4){__uint_as_float((unsigned)bw << 16), __uint_as_float((unsigned)bw & 0xffff0000u), __uint_as_float((unsigned)(bw >> 32) << 16), __uint_as_float((unsigned)(bw >> 32) & 0xffff0000u)}; }
            else x[i] = __builtin_nontemporal_load((const f32x4*)((const float*)basev + eo + 256 * i));
            f[i] = (f32x4){__uint_as_float((unsigned)w << 16), __uint_as_float((unsigned)w & 0xffff0000u), __uint_as_float((unsigned)(w >> 32) << 16), __uint_as_float((unsigned)(w >> 32) & 0xffff0000u)};
            s += (f[i].x * f[i].x + f[i].y * f[i].y) + (f[i].z * f[i].z + f[i].w * f[i].w); }
        const float rs = 1.0f / sqrtf(wave_sum(s) * (1.0f / DM) + EPS);
        float s1 = 0.f;
#pragma unroll
        for (int i = 0; i < 8; ++i) { x[i] = x[i] + f[i] * rs * gp[i];
            if (OUT_BF16) __builtin_nontemporal_store((unsigned long long)pk2(x[i].x, x[i].y) | ((unsigned long long)pk2(x[i].z, x[i].w) << 32), (unsigned long long*)((bf16*)outv + eo + 256 * i)); else __builtin_nontemporal_store(x[i], (f32x4*)((float*)outv + eo + 256 * i));
            s1 += (x[i].x * x[i].x + x[i].y * x[i].y) + (x[i].z * x[i].z + x[i].w * x[i].w); }
        if (HAS_H) {
            const float rs1 = 1.0f / sqrtf(wave_sum(s1) * (1.0f / DM) + EPS);
            if (HAS_H == 1 || HAS_H == 3) { bf16* ho = (bf16*)hout + (size_t)m * DM + 4 * ((int)threadIdx.x & 63);
#pragma unroll
                for (int i = 0; i < 8; ++i) { const f32x4 o = x[i] * rs1 * gq[i]; *(unsigned long long*)(ho + 256 * i) = (unsigned long long)pk2(o.x, o.y) | ((unsigned long long)pk2(o.z, o.w) << 32); } }
            if (HAS_H == 2 || HAS_H == 3) {
#pragma unroll
                for (int i = 0; i < 8; ++i) x[i] = x[i] * rs1 * gq[i];
                store_row_i8(x, (HAS_H == 2 ? (unsigned char*)hout : hout8) + (size_t)m * DM, sh + m); }
        }
    }
}

struct RecArgs { const bf16* XR; const bf16* GR; unsigned char* OUT  ; bf16* OL; bf16* CG  ; float* SSR  ;
                 const float *conv_w, *conv_b, *w_a, *b_a, *w_x, *b_x, *lam; };
__device__ __forceinline__ float sigmoidf_(float x) { return __builtin_amdgcn_rcpf(1.0f + __builtin_amdgcn_exp2f(-1.4426950408889634f * x)); }
constexpr int REC_XT = 35 * 144, REC_WAVE_LDS = 2 * REC_XT + 1024 + 2 * 1024 + 64;
static_assert(2048 + 8 * 14336 <= RING_BYTES && REC_WAVE_LDS <= 14336, "rec LDS");
__device__ __forceinline__ void rec_unit(Frame& F, const RecArgs& R, int b, int nb, int qq) {
    typedef float f32x4v __attribute__((ext_vector_type(4)));
    const int lane = (int)threadIdx.x & 63, wave = __builtin_amdgcn_readfirstlane((int)threadIdx.x >> 6), c = lane & 15, q = lane >> 4;
    const int ch = 64 * nb + 16 * qq + c;
    LAS float* sum = (LAS float*)(F.lds + RING_OFF);
    LAS unsigned char* wl = F.lds + RING_OFF + 2048 + wave * 14336;
    LAS unsigned char* gt = wl + 2 * REC_XT; LAS unsigned char* ot = gt + 1024; LAS unsigned char* ct = ot + 1024; LAS float* cinl = (LAS float*)(ct + 1024);
    bf16x8 ba[4][2], bx[4][2]; float bsa = 0.f, bsx = 0.f;
#pragma unroll
    for (int ks = 0; ks < 2; ++ks)
#pragma unroll
        for (int e = 0; e < 8; ++e) { const int k = 32 * ks + 8 * q + e; const size_t wi = ((size_t)nb * 64 + k) * 64 + 16 * qq + c; const float wa = R.w_a[wi], wx = R.w_x[wi];
            const float cbk = R.conv_b[64 * nb + k]; bsa = fmaf(cbk, wa, bsa); bsx = fmaf(cbk, wx, bsx);
#pragma unroll
            for (int tap = 0; tap < 4; ++tap) { const float cwk = R.conv_w[tap * RW + 64 * nb + k]; ba[tap][ks][e] = (short)f2bf(cwk * wa); bx[tap][ks][e] = (short)f2bf(cwk * wx); } }
    bsa += __shfl_xor(bsa, 16); bsa += __shfl_xor(bsa, 32); bsx += __shfl_xor(bsx, 16); bsx += __shfl_xor(bsx, 32);
    const float bac = R.b_a[ch] + bsa, bxc = R.b_x[ch] + bsx;
    const float lamv = R.lam[ch]; const float sp8 = -8.0f * log1pf(expf(-lamv)) * 1.4426950408889634f;
    const float cw0 = R.conv_w[ch], cw1 = R.conv_w[RW + ch], cw2 = R.conv_w[2 * RW + ch], cw3 = R.conv_w[3 * RW + ch], cbc = R.conv_b[ch];
    const size_t rowb = (size_t)b * SEQ;
    const int slot = nb * 4 + qq;
    const int trow = lane >> 1, thalf = lane & 1;
    v4u xq[5], gq;
#define REC_LOAD(tb_) do { _Pragma("unroll") for (int i_ = 0; i_ < 5; ++i_) { const int id_ = lane + 64 * i_, tt_ = (tb_) - 3 + (id_ >> 3); xq[i_] = (v4u){0u, 0u, 0u, 0u}; \
        if (id_ < 280 && tt_ >= 0) xq[i_] = *(const v4u*)(R.XR + (rowb + tt_) * RW + 64 * nb + 8 * (id_ & 7)); } \
        gq = __builtin_nontemporal_load((const v4u*)(R.GR + (rowb + (tb_) + trow) * RW + 64 * nb + 16 * qq + 8 * thalf)); } while (0)
    REC_LOAD(wave * 512);
    float st = 0.f, Pst = 1.f;
    for (int it = 0; it < 16; ++it) {
        const int tb = wave * 512 + it * 32;
        LAS unsigned char* xt = wl + (it & 1) * REC_XT;
#pragma unroll
        for (int i = 0; i < 5; ++i) { const int id = lane + 64 * i; if (id < 280) *(LAS v4u*)(xt + (id >> 3) * 144 + (id & 7) * 16) = xq[i]; }
        *(LAS v4u*)(gt + trow * 32 + thalf * 16) = gq;
        asm volatile("" ::: "memory");
        if (it + 1 < 16) REC_LOAD(tb + 32);
        f32x4v gr_[2], gi_[2];
#pragma unroll
        for (int mt = 0; mt < 2; ++mt) { gr_[mt] = (f32x4v){0.f, 0.f, 0.f, 0.f}; gi_[mt] = gr_[mt];
#pragma unroll
            for (int tap = 0; tap < 4; ++tap)
#pragma unroll
                for (int ks = 0; ks < 2; ++ks) { const bf16x8 af = *(const LAS bf16x8*)(xt + (16 * mt + c + tap) * 144 + (32 * ks + 8 * q) * 2);
                    gr_[mt] = __builtin_amdgcn_mfma_f32_16x16x32_bf16(af, ba[tap][ks], gr_[mt], 0, 0, 0); gi_[mt] = __builtin_amdgcn_mfma_f32_16x16x32_bf16(af, bx[tap][ks], gi_[mt], 0, 0, 0); } }
        float av[2][4], uv[2][4], gl[2][4], P[2], Hs[2];
#pragma unroll
        for (int mt = 0; mt < 2; ++mt) {
            float xs[7];
#pragma unroll
            for (int i = 0; i < 7; ++i) xs[i] = bf2f(*(const LAS unsigned short*)(xt + (16 * mt + 4 * q + i) * 144 + (16 * qq + c) * 2));
#pragma unroll
            for (int j = 0; j < 4; ++j) { const float xcv = fmaf(cw3, xs[j + 3], fmaf(cw2, xs[j + 2], fmaf(cw1, xs[j + 1], fmaf(cw0, xs[j], cbc))));
                const float r = sigmoidf_(gr_[mt][j] + bac), ig = sigmoidf_(gi_[mt][j] + bxc);
                const float a = __builtin_amdgcn_exp2f(r * sp8); av[mt][j] = a; uv[mt][j] = __builtin_amdgcn_sqrtf(fmaxf(1.0f - a * a, 0.f)) * (ig * xcv);
                const float g = bf2f(*(const LAS unsigned short*)(gt + (16 * mt + 4 * q + j) * 32 + c * 2)); gl[mt][j] = g * sigmoidf_(1.5957691216057308f * (g + 0.044715f * g * g * g)); }
            P[mt] = (av[mt][0] * av[mt][1]) * (av[mt][2] * av[mt][3]);
            Hs[mt] = fmaf(fmaf(fmaf(uv[mt][0], av[mt][1], uv[mt][1]), av[mt][2], uv[mt][2]), av[mt][3], uv[mt][3]); }
        float sin_[2], pin_[2]; { float s_ = st, p_ = Pst;
#pragma unroll
            for (int mt = 0; mt < 2; ++mt)
#pragma unroll
                for (int q2 = 0; q2 < 4; ++q2) { const float ps = __shfl(P[mt], c + 16 * q2), hs = __shfl(Hs[mt], c + 16 * q2);
                    if (q2 == q) { sin_[mt] = s_; pin_[mt] = p_; } s_ = fmaf(ps, s_, hs); p_ *= ps; }
            st = s_; Pst = p_; }
#pragma unroll
        for (int mt = 0; mt < 2; ++mt) { float h = sin_[mt], p = pin_[mt];
#pragma unroll
            for (int j = 0; j < 4; ++j) { h = fmaf(av[mt][j], h, uv[mt][j]); p *= av[mt][j];
                const unsigned oc = pg8::cvt_pk_bf16(h * gl[mt][j], p * gl[mt][j]);
                *(LAS unsigned short*)(ot + (16 * mt + 4 * q + j) * 32 + c * 2) = (unsigned short)oc;
                *(LAS unsigned short*)(ct + (16 * mt + 4 * q + j) * 32 + c * 2) = (unsigned short)(oc >> 16); } }
        asm volatile("" ::: "memory");
        { const v4u ov = *(const LAS v4u*)(ot + trow * 32 + thalf * 16), cv = *(const LAS v4u*)(ct + trow * 32 + thalf * 16);
          *(v4u*)(R.OL + ((size_t)slot * M + rowb + tb + trow) * 16 + 8 * thalf) = ov;
          *(v4u*)(R.CG + ((size_t)slot * M + rowb + tb + trow) * 16 + 8 * thalf) = cv; }
        asm volatile("" ::: "memory");
    }
#undef REC_LOAD
    if (q == 0) { sum[(wave * 16 + c) * 2] = Pst; sum[(wave * 16 + c) * 2 + 1] = st; }
    VM_WAIT(); __syncthreads();
    float cin = 0.f;
    for (int w2 = 0; w2 < wave; ++w2) cin = fmaf(sum[(w2 * 16 + c) * 2], cin, sum[(w2 * 16 + c) * 2 + 1]);
    if (q == 0) cinl[c] = cin;
    asm volatile("" ::: "memory");
    const f32x4v ci0 = *(const LAS f32x4v*)(cinl + 8 * thalf), ci1 = *(const LAS f32x4v*)(cinl + 8 * thalf + 4);
    const float cc[8] = {ci0[0], ci0[1], ci0[2], ci0[3], ci1[0], ci1[1], ci1[2], ci1[3]};
    for (int it = 0; it < 16; ++it) { const size_t row = rowb + wave * 512 + it * 32 + trow;
        const v4u ov = *(const v4u*)(R.OL + ((size_t)slot * M + row) * 16 + 8 * thalf), cv = *(const v4u*)(R.CG + ((size_t)slot * M + row) * 16 + 8 * thalf);
        const unsigned ow[4] = {ov.x, ov.y, ov.z, ov.w}, cw_[4] = {cv.x, cv.y, cv.z, cv.w}; float o[8]; float s2 = 0.f;
#pragma unroll
        for (int e = 0; e < 4; ++e) { o[2 * e] = fmaf(cc[2 * e], __uint_as_float(cw_[e] << 16), __uint_as_float(ow[e] << 16)); o[2 * e + 1] = fmaf(cc[2 * e + 1], __uint_as_float(cw_[e] & 0xffff0000u), __uint_as_float(ow[e] & 0xffff0000u));
            s2 = fmaf(o[2 * e], o[2 * e], fmaf(o[2 * e + 1], o[2 * e + 1], s2)); }
        typedef unsigned u32x2v __attribute__((ext_vector_type(2)));
#pragma unroll
        for (int e = 0; e < 8; ++e) o[e] = __builtin_amdgcn_fmed3f(4.f * o[e], -448.0f, 448.0f);
        u32x2v w8; w8.x = pg8::cvt4_fp8(o[0], o[1], o[2], o[3]); w8.y = pg8::cvt4_fp8(o[4], o[5], o[6], o[7]);
        *(u32x2v*)(R.OUT + row * DM + AW + 64 * nb + 16 * qq + 8 * thalf) = w8;
        s2 += __shfl_xor(s2, 1);
        if (thalf == 0) R.SSR[(size_t)slot * M + row] = s2; }
    __syncthreads();
}
struct Args { const float* in[22]; float* out; unsigned char* ws; double invf[16]; int ph_lo, ph_hi, li, pad; };
__global__ void __launch_bounds__(NWAVES * 64, 2) hyb_fwd(Args args) {
    extern __shared__ __attribute__((aligned(16))) unsigned char lds[];
    Frame F;
    F.lds = (LAS unsigned char*)lds;
    F.MISC = (volatile LAS unsigned*)(F.lds + MISC_OFF);
    F.G = gridDim.x; { const int bx = blockIdx.x; F.vcu = (F.G % 8 == 0) ? (bx % 8) * (F.G / 8) + bx / 8 : bx; }
    unsigned char* ws = args.ws;
    F.ctl = (gu32*)(ws + WS_CTL);
#define GRID_BAR(seam) do { if (N_LAUNCHES != 1) { if (((int)threadIdx.x) == 0) __hip_atomic_store(F.ctl + CW_TMO, 0xBADBA0u | (unsigned)(seam), RLX_AGENT); } else { xcd_barrier(bar); } } while (0)
    const float* x = args.in[0];
    unsigned char* Wgu1 = ws + WS_WGU1; unsigned char* Wd1 = ws + WS_WD1; float* swgu1 = (float*)(ws + WS_SC); float* swgu2 = (float*)(ws + WS_SC + 65536); float* swkvxg = (float*)(ws + WS_SC + 131072); float* shrow = (float*)(ws + WS_SC + 196608); unsigned char* Wkvxg = ws + WS_WIN;   unsigned char* Wout8 = ws + WS_WOUT; unsigned char* H8B = ws + WS_CG;
    unsigned char* Wgu2 = ws + WS_WGU2; unsigned char* Wd2 = ws + WS_WD2;
    bf16* H = (bf16*)(ws + WS_H); unsigned char* H8 = ws + WS_H; bf16* ACT = (bf16*)(ws + WS_ACT); unsigned char* ACT8 = ws + WS_ACT;
    bf16* Qh = (bf16*)(ws + WS_ACT + ACT_Q); bf16* Kh = (bf16*)(ws + WS_ACT + ACT_K); bf16* Vh = (bf16*)(ws + WS_ACT + ACT_V);
    bf16* XR = (bf16*)(ws + WS_ACT + ACT_XR); bf16* GR = (bf16*)(ws + WS_ACT + ACT_GR); bf16* Y = (bf16*)(ws + WS_ACT);
    float* rope = (float*)(ws + WS_ROPE); float* kmean = (float*)(ws + WS_KMEAN); float* ssa = (float*)(ws + WS_SSA); float* ssr = (float*)(ws + WS_SSR);
    float* out = args.out; bf16* XRES = (bf16*)(ws + WS_WGU1);
    for (int u = ((int)threadIdx.x); u < (LDS_BYTES - LDSCTL_OFF) / 4; u += NWAVES * 64) ((LAS unsigned*)(F.lds + LDSCTL_OFF))[u] = 0u;
    __syncthreads();
    XcdBarrier bar; bar.bar = (unsigned*)(F.ctl + CW_BAR); bar.x = 0; bar.st = nullptr;
    if (N_LAUNCHES == 1) bar = xcd_barrier_post((unsigned*)(F.ctl + CW_BAR), F.MISC + 8);
    const int lo = args.ph_lo, hi = args.ph_hi;
#ifndef PH_MASK
#define PH_MASK 0x7ff
#endif
#define IN(k) ((((PH_MASK) >> (k)) & 1) && lo <= (k) && (k) < hi)
#define BOTH(k) (IN(k) && IN((k) + 1))

    if (IN(0)) {
        LAS float* scr = (LAS float*)(F.lds + RING_OFF + __builtin_amdgcn_readfirstlane((int)threadIdx.x >> 6) * 16384);
        const int gw = F.vcu * NWAVES + __builtin_amdgcn_readfirstlane((int)threadIdx.x >> 6), NGW = F.G * NWAVES;
        for (int i = blockIdx.x * (NWAVES * 64) + ((int)threadIdx.x); i < SEQ * 16; i += F.G * NWAVES * 64) { float c, s; sincos_tab((double)(i >> 4) * args.invf[i & 15], c, s); rope[2 * i] = c; rope[2 * i + 1] = s; }
        for (int i = blockIdx.x * (NWAVES * 64) + (int)threadIdx.x; i < BATCH * NH * 16 * 128 / 4; i += F.G * NWAVES * 64) ((f32x4*)kmean)[i] = (f32x4){0.f, 0.f, 0.f, 0.f};
        {
          const int c = (int)blockIdx.x, G = F.G, o1 = NGU / 32, o2 = o1 + INC / 32;
          quant_strips_i8(F, args.in[2], NGU, Wgu1, swgu1, true, c % G, NGU / 32, G);
          quant_strips_i8(F, args.in[6], INC, Wkvxg, swkvxg, false, ((c - o1) % G + G) % G, INC / 32, G, true);
          quant_strips_i8(F, args.in[19], NGU, Wgu2, swgu2, true, ((c - o2) % G + G) % G, P0_GU2, G, true); }
        rms_rows(F, x, args.in[1], H8, shrow);
        transpose_matrix_f8(F, args.in[16], AW, DM, DM, Wout8, DM, 32.0f, args.in[14], false, scr, gw, NGW, true);
        transpose_matrix_f8(F, args.in[16] + (size_t)AW * DM, RW, DM, DM, Wout8 + AW, DM, 32.0f, args.in[15], false, scr, gw, NGW, true);
        if (BOTH(0)) GRID_BAR(0);
    }
    if (IN(1)) {
        pg8::Gemm g{(const bf16*)H8, (const bf16*)Wgu1, M, NGU, DM / 2}; pg8::StaticOrder S; S.init(M, NGU, F.G, (int)blockIdx.x);
        pg8::EpiSwiGLUI8 E{ACT8, DFFP, shrow, swgu1, NGU / 256 - 1};
        pg8::gemm_phase<pg8::EpiSwiGLUI8, pg8::StaticOrder, pg8::NoMid, true, true, 2>(F.lds + RING_OFF, g, S, E, pg8::NoMid{});
        {
          const int rem = ((M / 256) * (NGU / 256)) % F.G, first = rem, nfill = F.G - first;
          if ((int)blockIdx.x >= first) { LAS float* scr = (LAS float*)(F.lds + RING_OFF + __builtin_amdgcn_readfirstlane((int)threadIdx.x >> 6) * 16384);
              const int gwf = ((int)blockIdx.x - first) * NWAVES + __builtin_amdgcn_readfirstlane((int)threadIdx.x >> 6);
              transpose_matrix_f8(F, args.in[3], DFF, DM, DM, Wd1, DFFP, 64.0f, nullptr, false, scr, gwf, nfill * NWAVES);
              for (int i = ((int)blockIdx.x - first) * (NWAVES * 64) + (int)threadIdx.x; i < DM * 8; i += nfill * NWAVES * 64) *(v4u*)(Wd1 + (size_t)(i >> 3) * DFFP + DFF + 16 * (i & 7)) = (v4u){0u, 0u, 0u, 0u};
              __syncthreads();
              quant_strips_i8(F, args.in[19], NGU, Wgu2, swgu2, true, P0_GU2 + (int)blockIdx.x - first, NGU / 32, nfill, true); } }
        if (BOTH(1)) GRID_BAR(1);
    }
    if (IN(2)) {
        pg8::Gemm g{(const bf16*)ACT8, (const bf16*)Wd1, M, DM, DFFP / 2}; pg8::StaticOrder S; S.init(M, DM, F.G, (int)blockIdx.x);
        pg8::EpiBf16 E{H, DM, 1.0f / 256.0f};
        pg8::gemm_phase<pg8::EpiBf16, pg8::StaticOrder, pg8::NoMid, true, true, true>(F.lds + RING_OFF, g, S, E, pg8::NoMid{});
        if (BOTH(2)) GRID_BAR(2);
    }
    if (IN(3)) {
        norm_res_rows<2, false, true>(F, H, x, XRES, H8B, nullptr, shrow, args.in[4], args.in[5], 0.5f);
        if (BOTH(3)) GRID_BAR(3);
    }
    if (IN(4)) {
        { pg8::Gemm g{(const bf16*)H8B, (const bf16*)Wkvxg, M, INC, DM / 2}; pg8::StaticOrder S; S.init(M, INC, F.G, (int)blockIdx.x);
          pg8::EpiKVXG E{ws + WS_ACT, shrow, swkvxg, rope, kmean};
          pg8::gemm_phase<pg8::EpiKVXG, pg8::StaticOrder, pg8::NoMid, true, true, 2>(F.lds + RING_OFF, g, S, E, pg8::NoMid{}); }
        if (BOTH(4)) GRID_BAR(4);
    }
    if (IN(5)) {
        char* al = (char*)lds + RING_OFF;
#ifndef NO_ATT
        for (int L = blockIdx.x; L < BATCH * NH * 8; L += F.G) {
            const int bh = (L & 7) * 4 + (L >> 6), y = (L >> 3) & 7, b = bh >> 3, h = bh & 7;
            const bf16* qb = Qh + (size_t)bh * SEQ * HD; const bf16* kb = Kh + (size_t)bh * SEQ * HD; const bf16* vb = Vh + (size_t)bh * SEQ * HD;
            moba::BlockRef r0, r1;
            r0.Q = qb + (size_t)(y * 256) * HD; r0.K = kb; r0.V = vb; r0.O = H8 + ((size_t)b * SEQ + y * 256) * DM + h * HD; r0.SS = ssa + (size_t)h * M + (size_t)b * SEQ + y * 256; r0.KM = kmean + (size_t)bh * 16 * 128; r0.P0 = y * 256;
            const int y1 = 15 - y;
            r1.Q = qb + (size_t)(y1 * 256) * HD; r1.K = kb; r1.V = vb; r1.O = H8 + ((size_t)b * SEQ + y1 * 256) * DM + h * HD; r1.SS = ssa + (size_t)h * M + (size_t)b * SEQ + y1 * 256; r1.KM = r0.KM; r1.P0 = y1 * 256;
            moba::moba_block_t16(r0, al, F.lds + RING_OFF);
            moba::moba_block_t16(r1, al, F.lds + RING_OFF);
            VM_WAIT(); __syncthreads();
        }
#endif
#ifndef NO_REC
        RecArgs R{XR, GR, H8, (bf16*)(ws + WS_OL), (bf16*)(ws + WS_CG), ssr, args.in[7], args.in[8], args.in[9], args.in[10], args.in[11], args.in[12], args.in[13]};
        for (int L = blockIdx.x; L < BATCH * NRB * 4; L += F.G) { const int bn = (L & 7) | ((L >> 5) << 3);
            rec_unit(F, R, bn >> 4, bn & 15, (L >> 3) & 3); }
#endif
        if (BOTH(5)) GRID_BAR(5);
    }
    if (IN(6)) {
        pg8::Gemm g{(const bf16*)H8, (const bf16*)Wout8, M, DM, DM / 2}; pg8::StaticOrder S; S.init(M, DM, F.G, (int)blockIdx.x);
        LAS float* scl = (LAS float*)(F.lds + SCL_OFF);
        { pg8::Unit u;
          for (int i0 = 0; i0 < 4; i0 += 2) { const int i = i0 + (((int)threadIdx.x) >> 8), r = ((int)threadIdx.x) & 255;
              if (S.next(i, u)) { const size_t row = (size_t)u.pm * 256 + r; float sa = 0.f, sr = 0.f;
#pragma unroll
              for (int hh = 0; hh < 8; ++hh) sa += ssa[(size_t)hh * M + row];
#pragma unroll
              for (int s = 0; s < 64; ++s) sr += ssr[(size_t)s * M + row];
              const float ra = 1.0f / sqrtf(sa * (1.0f / AW) + EPS), rr = 1.0f / sqrtf(sr * (1.0f / RW) + EPS);
              scl[(i * 256 + r) * 2] = 0.25f * ra / rr; scl[(i * 256 + r) * 2 + 1] = rr * (1.0f / 128.0f); } }
          __syncthreads(); }
        pg8::EpiRowScaleBf16 E{Y, DM, (const PG8_LAS float*)scl}; pg8::MidRowScale MH{(const PG8_LAS float*)scl};
        pg8::gemm_phase<pg8::EpiRowScaleBf16, pg8::StaticOrder, pg8::MidRowScale, true, true, true>(F.lds + RING_OFF, g, S, E, MH);
        if (BOTH(6)) GRID_BAR(6);
    }
    if (IN(7)) {
        norm_res_rows<2, true, true>(F, Y, XRES, XRES, H8, nullptr, shrow, args.in[17], args.in[18], 1.0f);
        if (BOTH(7)) GRID_BAR(7);
    }
    if (IN(8)) {
        pg8::Gemm g{(const bf16*)H8, (const bf16*)Wgu2, M, NGU, DM / 2}; pg8::StaticOrder S; S.init(M, NGU, F.G, (int)blockIdx.x);
        pg8::EpiSwiGLUI8 E{ACT8, DFFP, shrow, swgu2, NGU / 256 - 1};
        pg8::gemm_phase<pg8::EpiSwiGLUI8, pg8::StaticOrder, pg8::NoMid, true, true, 2>(F.lds + RING_OFF, g, S, E, pg8::NoMid{});
        {
          const int rem = ((M / 256) * (NGU / 256)) % F.G, first = rem, nfill = F.G - first;
          if ((int)blockIdx.x >= first) { const int wv = __builtin_amdgcn_readfirstlane((int)threadIdx.x >> 6); LAS float* scr = (LAS float*)(F.lds + RING_OFF + wv * 16384);
              transpose_matrix_f8(F, args.in[20], DFF, DM, DM, Wd2, DFFP, 64.0f, nullptr, false, scr, ((int)blockIdx.x - first) * NWAVES + wv, nfill * NWAVES);
              for (int i = ((int)blockIdx.x - first) * (NWAVES * 64) + (int)threadIdx.x; i < DM * 8; i += nfill * NWAVES * 64) *(v4u*)(Wd2 + (size_t)(i >> 3) * DFFP + DFF + 16 * (i & 7)) = (v4u){0u, 0u, 0u, 0u}; } }
        if (BOTH(8)) GRID_BAR(8);
    }
    if (IN(9)) {
        pg8::Gemm g{(const bf16*)ACT8, (const bf16*)Wd2, M, DM, DFFP / 2}; pg8::StaticOrder S; S.init(M, DM, F.G, (int)blockIdx.x);
        pg8::EpiBf16 E{H, DM, 1.0f / 256.0f};
        pg8::gemm_phase<pg8::EpiBf16, pg8::StaticOrder, pg8::NoMid, true, true, true>(F.lds + RING_OFF, g, S, E, pg8::NoMid{});
        if (BOTH(9)) GRID_BAR(9);
    }
    if (IN(10)) {
        norm_res_rows<0, true, false>(F, H, XRES, out, nullptr, nullptr, nullptr, args.in[21], nullptr, 0.5f);
    }
#undef IN
#undef BOTH
}

extern "C" void kernel_launch(void* const* d_in, const int* in_sizes, int n_in, void* d_out, int out_size, void* d_ws, size_t ws_size, hipStream_t stream) {
    static int grid = 0;
    if (grid == 0) {
        if (n_in != 22 || in_sizes[0] != M * DM || out_size != M * DM || ws_size < WS_END) { fprintf(stderr, "kernel_launch: unexpected shapes (n_in %d, in0 %d, out %d, ws %zu)\n", n_in, n_in > 0 ? in_sizes[0] : -1, out_size, ws_size); grid = -1; return; }
        int dev = 0, cus = 0, per_cu = 0;
        if (hipGetDevice(&dev) != hipSuccess || hipDeviceGetAttribute(&cus, hipDeviceAttributeMultiprocessorCount, dev) != hipSuccess) { grid = -1; return; }
        if (hipFuncSetAttribute((const void*)hyb_fwd, hipFuncAttributeMaxDynamicSharedMemorySize, LDS_BYTES) != hipSuccess) { fprintf(stderr, "kernel_launch: hipFuncSetAttribute failed\n"); grid = -1; return; }
        if (hipOccupancyMaxActiveBlocksPerMultiprocessor(&per_cu, (const void*)hyb_fwd, NWAVES * 64, LDS_BYTES) != hipSuccess || per_cu < 1)
            fprintf(stderr, "kernel_launch: note: occupancy query reports %d workgroups per CU\n", per_cu);
        (void)hipGetLastError();
        grid = cus;
    }
    if (grid < 0) return;
    if (hipMemsetAsync((char*)d_ws + WS_CTL, 0, CTL_ZERO_BYTES, stream) != hipSuccess) return;
    Args a{};
    for (int i = 0; i < 22; ++i) a.in[i] = (const float*)d_in[i];
    a.out = (float*)d_out; a.ws = (unsigned char*)d_ws;
    for (int f = 0; f < 16; ++f) a.invf[f] = pow(500000.0, -(double)f / 16.0);
    for (int li = 0; li < N_LAUNCHES; ++li) {
        a.ph_lo = (N_LAUNCHES == 1) ? 0 : li; a.ph_hi = (N_LAUNCHES == 1) ? N_PHASES : li + 1; a.li = li; a.pad = 0;
        hipLaunchKernelGGL(hyb_fwd, dim3(grid), dim3(NWAVES * 64), LDS_BYTES, stream, a);
        const hipError_t le = hipPeekAtLastError();
        if (le != hipSuccess) { fprintf(stderr, "kernel_launch: launch %d failed: %s\n", li, hipGetErrorName(le)); break; }
#ifdef DUP_PHASE
        if (N_LAUNCHES == N_PHASES && li == DUP_PHASE) hipLaunchKernelGGL(hyb_fwd, dim3(grid), dim3(NWAVES * 64), LDS_BYTES, stream, a);
#endif
    }
}
```

```cpp
#include <hip/hip_runtime.h>
#include <cstdio>
#include <cstdint>
#include <cmath>
namespace pg8 {
#define PG8_LAS __attribute__((address_space(3)))
typedef unsigned short bf16_t;
typedef short bf16x8 __attribute__((ext_vector_type(8)));
typedef float f32x4 __attribute__((ext_vector_type(4)));
typedef unsigned u32x4 __attribute__((ext_vector_type(4)));
constexpr int BM = 256, BK = 64, HALF = 128, HTB = HALF * BK * 2  , STAGE_BYTES = 8 * HTB, NXCD = 8, WGM = 4;

__host__ __device__ __forceinline__ int lds_byte(int r, int c) { const int st = (r >> 4) * 2 + (c >> 5), rr = r & 15, cc = c & 31, ob = rr * 64 + cc * 2; return st * 1024 + (ob ^ (((ob >> 9) & 1) << 5)); }
__host__ __device__ __forceinline__ void stage_rc(int b, int& R, int& C) { const int st = b / 1024, sb = b % 1024, swz = sb ^ (((sb >> 9) & 1) << 5); R = (st >> 1) * 16 + swz / 64; C = (st & 1) * 32 + (swz % 64) / 2; }
__host__ __device__ __forceinline__ int perm32(int rho) { const int n = rho >> 4, i = rho & 15; return 8 * (i >> 2) + 4 * n + (i & 3); }

struct Unit { int pm, pn; };
struct Gemm { const bf16_t* A; const bf16_t* Bt; int M, N, K; };

struct StaticOrder {
    int nM, nN, nwg, G, c;
    __host__ __device__ __forceinline__ void init(int M, int N, int G_, int c_) { nM = M / BM; nN = N / BM; nwg = nM * nN; G = G_; c = c_; }
    __host__ __device__ __forceinline__ bool next(int i, Unit& u) const {
        const long L = (long)i * G + c; if (L >= nwg) return false;
        int wgid = (int)L; { const int q = nwg / NXCD, r = nwg % NXCD, xcd = wgid % NXCD, off = wgid / NXCD; wgid = (xcd < r ? xcd * (q + 1) : r * (q + 1) + (xcd - r) * q) + off; }
        const int nig = WGM * nN, gid = wgid / nig, fm = gid * WGM, gsz = (nM - fm) < WGM ? (nM - fm) : WGM;
        u.pm = fm + ((wgid % nig) % gsz); u.pn = (wgid % nig) / gsz; return true;
    }
    __device__ __forceinline__ void a_ready(const Unit&) const {}
    __device__ __forceinline__ void done(const Unit&) const {}
};

__device__ __forceinline__ unsigned cvt_pk_bf16(float lo, float hi) { unsigned r; asm volatile("v_cvt_pk_bf16_f32 %0, %1, %2" : "=v"(r) : "v"(lo), "v"(hi)); return r; }
typedef float f32x2 __attribute__((ext_vector_type(2)));
typedef f32x4 Acc[2][2][4][2];

typedef int i32x4v __attribute__((ext_vector_type(4)));
typedef int i32x8v __attribute__((ext_vector_type(8)));
__device__ __forceinline__ i32x8v cat8(bf16x8 a, bf16x8 b) { const i32x4v x = __builtin_bit_cast(i32x4v, a), y = __builtin_bit_cast(i32x4v, b); return __builtin_shufflevector(x, y, 0, 1, 2, 3, 4, 5, 6, 7); }
__device__ __forceinline__ unsigned cvt4_fp8(float a, float b, float c, float d) { int w = __builtin_amdgcn_cvt_pk_fp8_f32(a, b, 0, false); w = __builtin_amdgcn_cvt_pk_fp8_f32(c, d, w, true); return (unsigned)w; }
struct NoMid { static constexpr bool ENABLED = false; __device__ __forceinline__ void operator()(Acc&, int, int, int) const {} };

struct EpiBf16 {
    static constexpr bool PERM = true, AFTER_DRAIN = false;
    bf16_t* O; int ldc; float sc;
    __device__ __forceinline__ void operator()(Acc& acc, const Unit& u, int ui, int wr, int wc, int fr, int fq) const {
        const int row0 = u.pm * BM + wr * 64 + fr, col0 = u.pn * BM + wc * 32 + 8 * fq;
#pragma unroll
        for (int ai = 0; ai < 2; ++ai)
#pragma unroll
            for (int m = 0; m < 4; ++m) { bf16_t* rowp = O + (size_t)(row0 + ai * HALF + m * 16) * ldc + col0;
#pragma unroll
                for (int bj = 0; bj < 2; ++bj) { const f32x4 v0 = acc[ai][bj][m][0] * sc, v1 = acc[ai][bj][m][1] * sc;
                    u32x4 w; w.x = cvt_pk_bf16(v0[0], v0[1]); w.y = cvt_pk_bf16(v0[2], v0[3]); w.z = cvt_pk_bf16(v1[0], v1[1]); w.w = cvt_pk_bf16(v1[2], v1[3]);
                    *(u32x4*)(rowp + bj * HALF) = w; } }
    }
};
struct MidRowScale {
    static constexpr bool ENABLED = true;
    const PG8_LAS float* scl;
    __device__ __forceinline__ void operator()(Acc& acc, int ui, int wr, int fr) const {
#pragma unroll
        for (int ai = 0; ai < 2; ++ai)
#pragma unroll
            for (int m = 0; m < 4; ++m) { const float s = scl[(ui * 256 + ai * HALF + wr * 64 + m * 16 + fr) * 2];
#pragma unroll
                for (int bj = 0; bj < 2; ++bj)
#pragma unroll
                    for (int n = 0; n < 2; ++n) acc[ai][bj][m][n] = acc[ai][bj][m][n] * s; }
    }
};
struct EpiRowScaleBf16 {
    static constexpr bool PERM = true, AFTER_DRAIN = false;
    bf16_t* O; int ldc; const PG8_LAS float* scl;
    __device__ __forceinline__ void operator()(Acc& acc, const Unit& u, int ui, int wr, int wc, int fr, int fq) const {
        const int row0 = u.pm * BM + wr * 64 + fr, col0 = u.pn * BM + wc * 32 + 8 * fq;
#pragma unroll
        for (int ai = 0; ai < 2; ++ai)
#pragma unroll
            for (int m = 0; m < 4; ++m) { bf16_t* rowp = O + (size_t)(row0 + ai * HALF + m * 16) * ldc + col0;
                const float s = scl[(ui * 256 + ai * HALF + wr * 64 + m * 16 + fr) * 2 + 1];
#pragma unroll
                for (int bj = 0; bj < 2; ++bj) { const f32x4 v0 = acc[ai][bj][m][0] * s, v1 = acc[ai][bj][m][1] * s;
                    u32x4 w; w.x = cvt_pk_bf16(v0[0], v0[1]); w.y = cvt_pk_bf16(v0[2], v0[3]); w.z = cvt_pk_bf16(v1[0], v1[1]); w.w = cvt_pk_bf16(v1[2], v1[3]);
                    *(u32x4*)(rowp + bj * HALF) = w; } }
    }
};
typedef int i32x4e __attribute__((ext_vector_type(4)));
__device__ __forceinline__ f32x4 acc_i2f(f32x4 a) { return __builtin_convertvector(__builtin_bit_cast(i32x4e, a), f32x4); }
struct EpiSwiGLUI8 {
    static constexpr bool PERM = true, AFTER_DRAIN = false;
    unsigned char* O; int ldc; const float* sh; const float* sw; int last_pn;
    static constexpr bool PREFETCH = true;
    __device__ __forceinline__ void stage(const Unit& u, int wid, int lane, PG8_LAS unsigned char* sb) const {
        const char* base = (const char*)(wid < 4 ? sw + u.pn * BM + wid * 64 : sh + u.pm * BM + (wid - 4) * 64); asm volatile("" : "+s"(base)); unsigned lo = (unsigned)lane * 4u; asm volatile("" : "+v"(lo));
        __builtin_amdgcn_global_load_lds((const unsigned*)(base + lo), (PG8_LAS unsigned*)(sb + wid * 256), 4, 0, 0);
    }
    __device__ __forceinline__ void operator()(Acc& acc, const Unit& u, int ui, int wr, int wc, int fr, int fq, const PG8_LAS unsigned char* sb) const {
        const int row0 = u.pm * BM + wr * 64 + fr, col0 = u.pn * HALF + wc * 32 + 8 * fq;
        const PG8_LAS float* swl = (const PG8_LAS float*)sb + wc * 32 + 8 * fq; const PG8_LAS float* shl = (const PG8_LAS float*)sb + 256 + wr * 64 + fr;
        const f32x4 sg[2] = {*(const PG8_LAS f32x4*)swl, *(const PG8_LAS f32x4*)(swl + 4)}, su[2] = {*(const PG8_LAS f32x4*)(swl + HALF) * 4.0f, *(const PG8_LAS f32x4*)(swl + HALF + 4) * 4.0f};
        float shrv[8];
#pragma unroll
        for (int i = 0; i < 8; ++i) shrv[i] = shl[(i >> 2) * HALF + (i & 3) * 16];
#pragma unroll
        for (int ai = 0; ai < 2; ++ai)
#pragma unroll
            for (int m = 0; m < 4; ++m) { const int row = row0 + ai * HALF + m * 16; unsigned char* rowp = O + (size_t)row * ldc + col0; const float shr = shrv[ai * 4 + m];
                typedef unsigned u32x2v __attribute__((ext_vector_type(2)));
                u32x2v w;
#pragma unroll
                for (int n = 0; n < 2; ++n) { const f32x4 g = acc_i2f(acc[ai][0][m][n]) * (sg[n] * shr), uu = acc_i2f(acc[ai][1][m][n]) * (su[n] * shr);
                    f32x4 e = g * -1.4426950408889634f; e = (f32x4){__builtin_amdgcn_exp2f(e[0]), __builtin_amdgcn_exp2f(e[1]), __builtin_amdgcn_exp2f(e[2]), __builtin_amdgcn_exp2f(e[3])} + 1.0f;
                    const f32x4 r = (f32x4){__builtin_amdgcn_rcpf(e[0]), __builtin_amdgcn_rcpf(e[1]), __builtin_amdgcn_rcpf(e[2]), __builtin_amdgcn_rcpf(e[3])}, v = (g * uu) * r;
                    const unsigned q8 = cvt4_fp8(__builtin_amdgcn_fmed3f(v[0], -448.f, 448.f), __builtin_amdgcn_fmed3f(v[1], -448.f, 448.f), __builtin_amdgcn_fmed3f(v[2], -448.f, 448.f), __builtin_amdgcn_fmed3f(v[3], -448.f, 448.f));
                    if (n == 0) w.x = q8; else w.y = q8; }
                *(u32x2v*)rowp = w; if (u.pn == last_pn) *(u32x2v*)(rowp + HALF) = (u32x2v){0u, 0u}; }
    }
};
struct EpiKVXG {
    static constexpr bool PERM = true, AFTER_DRAIN = false;
    unsigned char* base5; const float* sh; const float* sw; const float* rope; float* kmean;
    __device__ __forceinline__ void operator()(Acc& acc, const Unit& u, int ui, int wr, int wc, int fr, int fq) const {
        const int region = u.pn >> 2, sub = u.pn & 3;
        const float qsc = region == 0 ? 0.12751743074602467f : 1.0f;
        { const float* swp = sw + u.pn * BM + wc * 32 + 8 * fq;
#pragma unroll
          for (int bj = 0; bj < 2; ++bj) { const f32x4 s0 = *(const f32x4*)(swp + bj * HALF), s1 = *(const f32x4*)(swp + bj * HALF + 4);
#pragma unroll
              for (int ai = 0; ai < 2; ++ai)
#pragma unroll
                  for (int m = 0; m < 4; ++m) { const float shr = sh[u.pm * BM + wr * 64 + fr + ai * HALF + m * 16] * qsc;
                      acc[ai][bj][m][0] = acc_i2f(acc[ai][bj][m][0]) * (s0 * shr); acc[ai][bj][m][1] = acc_i2f(acc[ai][bj][m][1]) * (s1 * shr); } } }
        bf16_t* dst = (bf16_t*)(base5 + (size_t)region * (32u << 20));
        const int b = u.pm >> 4, blk = u.pm & 15, s0 = blk * 256 + wr * 64 + fr;
        if (region <= 1) {
            bf16_t* base = dst + ((size_t)(b * 8 + sub * 2) * 4096 + s0) * 128 + wc * 32 + 8 * fq;
            f32x4 ks[2][2];
#pragma unroll
            for (int bj = 0; bj < 2; ++bj)
#pragma unroll
                for (int n = 0; n < 2; ++n) ks[bj][n] = (f32x4){0.f, 0.f, 0.f, 0.f};
            if (wc == 0) {
                const float sgn = fq < 2 ? -1.0f : 1.0f;
                const float* rp = rope + ((size_t)s0 * 16 + 8 * (fq & 1)) * 2;
#pragma unroll
                for (int ai = 0; ai < 2; ++ai)
#pragma unroll
                    for (int m = 0; m < 4; ++m) { const f32x4* cs = (const f32x4*)(rp + (size_t)(ai * HALF + m * 16) * 32);
#pragma unroll
                        for (int bj = 0; bj < 2; ++bj) { f32x4 o[2];
#pragma unroll
                            for (int n = 0; n < 2; ++n) { const f32x4 ca = cs[2 * n], cb = cs[2 * n + 1]; const f32x4 v = acc[ai][bj][m][n];
                                const f32x4 p = (f32x4){__shfl_xor(v[0], 32), __shfl_xor(v[1], 32), __shfl_xor(v[2], 32), __shfl_xor(v[3], 32)};
                                o[n] = (f32x4){fmaf(sgn * p[0], ca[1], v[0] * ca[0]), fmaf(sgn * p[1], ca[3], v[1] * ca[2]), fmaf(sgn * p[2], cb[1], v[2] * cb[0]), fmaf(sgn * p[3], cb[3], v[3] * cb[2])}; }
                            u32x4 w; w.x = cvt_pk_bf16(o[0][0], o[0][1]); w.y = cvt_pk_bf16(o[0][2], o[0][3]); w.z = cvt_pk_bf16(o[1][0], o[1][1]); w.w = cvt_pk_bf16(o[1][2], o[1][3]);
                            *(u32x4*)(base + (size_t)bj * 4096 * 128 + (size_t)(ai * HALF + m * 16) * 128) = w;
                            ks[bj][0] += o[0]; ks[bj][1] += o[1]; } }
            } else {
#pragma unroll
                for (int ai = 0; ai < 2; ++ai)
#pragma unroll
                    for (int m = 0; m < 4; ++m)
#pragma unroll
                        for (int bj = 0; bj < 2; ++bj) { const f32x4 v0 = acc[ai][bj][m][0], v1 = acc[ai][bj][m][1];
                            u32x4 w; w.x = cvt_pk_bf16(v0[0], v0[1]); w.y = cvt_pk_bf16(v0[2], v0[3]); w.z = cvt_pk_bf16(v1[0], v1[1]); w.w = cvt_pk_bf16(v1[2], v1[3]);
                            *(u32x4*)(base + (size_t)bj * 4096 * 128 + (size_t)(ai * HALF + m * 16) * 128) = w;
                            ks[bj][0] += v0; ks[bj][1] += v1; }
            }
            if (region == 1)
#pragma unroll
            for (int bj = 0; bj < 2; ++bj) { float* kd = kmean + ((size_t)(b * 8 + sub * 2 + bj) * 16 + blk) * 128 + wc * 32 + 8 * fq;
#pragma unroll
                for (int n = 0; n < 2; ++n)
#pragma unroll
                    for (int j = 0; j < 4; ++j) { float t = ks[bj][n][j]; t += __shfl_xor(t, 1); t += __shfl_xor(t, 2); t += __shfl_xor(t, 4); t += __shfl_xor(t, 8);
                        if (fr == 0) unsafeAtomicAdd(kd + 4 * n + j, t); } }
            return;
        }
        bf16_t* base = region == 2 ? dst + ((size_t)(b * 8 + sub * 2) * 4096 + s0) * 128 + wc * 32 + 8 * fq : dst + ((size_t)u.pm * BM + wr * 64 + fr) * 1024 + sub * BM + wc * 32 + 8 * fq;
        const size_t rstep = region == 2 ? 128 : 1024, bstep = region == 2 ? (size_t)4096 * 128 : 128;
#pragma unroll
        for (int ai = 0; ai < 2; ++ai)
#pragma unroll
            for (int m = 0; m < 4; ++m)
#pragma unroll
                for (int bj = 0; bj < 2; ++bj) { const f32x4 v0 = acc[ai][bj][m][0], v1 = acc[ai][bj][m][1];
                    u32x4 w; w.x = cvt_pk_bf16(v0[0], v0[1]); w.y = cvt_pk_bf16(v0[2], v0[3]); w.z = cvt_pk_bf16(v1[0], v1[1]); w.w = cvt_pk_bf16(v1[2], v1[3]);
                    *(u32x4*)(base + (size_t)bj * bstep + (size_t)(ai * HALF + m * 16) * rstep) = w; }
    }
};

template <class E, class = void> struct epi_prefetch { static constexpr bool value = false; };
template <class E> struct epi_prefetch<E, decltype((void)E::PREFETCH)> { static constexpr bool value = E::PREFETCH; };
template <class E, bool P> struct epi_state { };
template <class E> struct epi_state<E, true> { typename E::State s; };
template <class Epi, class Sched, class Mid, bool ALIGN_EPI = false, bool SP2 = false, int MODE = 0  >
__device__ __forceinline__ void gemm_phase(PG8_LAS unsigned char* lds, const Gemm g, const Sched& S, const Epi& E, const Mid& MH, PG8_LAS unsigned char* sclb = nullptr  ) {
    const int tid = threadIdx.x, wid = __builtin_amdgcn_readfirstlane(tid >> 6), lane = tid & 63, wr = wid >> 2, wc = wid & 3, fr = lane & 15, fq = lane >> 4;
    const int K = g.K, nt = K / BK;
    unsigned voffA[2], voffB[2];
#pragma unroll
    for (int i = 0; i < 2; ++i) { int R, C; stage_rc(tid * 16 + i * 8192, R, C); const int Rb = Epi::PERM ? ((R & ~31) + perm32(R & 31)) : R;
        voffA[i] = (unsigned)(R * K + C) * 2u; voffB[i] = (unsigned)(Rb * K + C) * 2u; }
    const size_t r64 = (size_t)64 * K * 2;
    const size_t kstep = (size_t)(BK * 2);
    const size_t hstep = (size_t)HALF * K * 2;
    const size_t tstep = 2 * hstep;
    const unsigned ldsw = (unsigned)wid * 1024u;
    const int aoff = lds_byte(wr * 64 + fr, fq * 8), boff = lds_byte(wc * 32 + fr, fq * 8);
#define PG8_SA(b, h) (((b) * 2 + (h)) * HTB)
#define PG8_SB(b, h) ((4 + (b) * 2 + (h)) * HTB)
#define PG8_STAGE(bufoff, gbase, voff) do { const char* gb_ = (const char*)(gbase); const char* gb1_ = gb_ + r64; asm volatile("" : "+s"(gb_), "+s"(gb1_));   \
        asm volatile("" : "+v"((voff)[0]));   \
        __builtin_amdgcn_global_load_lds((const unsigned*)(gb_ + (voff)[0]), (PG8_LAS unsigned*)(lds + (bufoff) + ldsw), 16, 0, 0); \
        __builtin_amdgcn_global_load_lds((const unsigned*)(gb1_ + (voff)[0]), (PG8_LAS unsigned*)(lds + (bufoff) + ldsw + 8192), 16, 0, 0); } while (0)
#define PG8_LDA(dst, b, h) do { _Pragma("unroll") for (int m = 0; m < 4; ++m) _Pragma("unroll") for (int k = 0; k < 2; ++k) dst[m][k] = *(const PG8_LAS bf16x8*)(lds + PG8_SA(b, h) + aoff + m * 2048 + k * 1024); } while (0)
#define PG8_LDB(dst, b, h) do { _Pragma("unroll") for (int n = 0; n < 2; ++n) _Pragma("unroll") for (int k = 0; k < 2; ++k) dst[n][k] = *(const PG8_LAS bf16x8*)(lds + PG8_SB(b, h) + boff + n * 2048 + k * 1024); } while (0)
#define PG8_MMA(ai, bj, At, Bt) do { __builtin_amdgcn_s_setprio(1); if constexpr (MODE == 1) { _Pragma("unroll") for (int m = 0; m < 4; ++m) _Pragma("unroll") for (int n = 0; n < 2; ++n) \
        { const i32x8v a8_ = cat8(Bt[n][0], Bt[n][1]), b8_ = cat8(At[m][0], At[m][1]); asm volatile("v_mfma_f32_16x16x128_f8f6f4 %0, %1, %2, %0" : "+v"(acc[ai][bj][m][n]) : "v"(a8_), "v"(b8_)); } } \
        else if constexpr (MODE == 2) { _Pragma("unroll") for (int m = 0; m < 4; ++m) _Pragma("unroll") for (int n = 0; n < 2; ++n) _Pragma("unroll") for (int k = 0; k < 2; ++k) \
        acc[ai][bj][m][n] = __builtin_bit_cast(f32x4, __builtin_amdgcn_mfma_i32_16x16x64_i8(__builtin_bit_cast(i32x4v, Bt[n][k]), __builtin_bit_cast(i32x4v, At[m][k]), __builtin_bit_cast(i32x4v, acc[ai][bj][m][n]), 0, 0, 0)); } \
        else { _Pragma("unroll") for (int m = 0; m < 4; ++m) _Pragma("unroll") for (int n = 0; n < 2; ++n) _Pragma("unroll") for (int k = 0; k < 2; ++k) \
        acc[ai][bj][m][n] = __builtin_amdgcn_mfma_f32_16x16x32_bf16(Bt[n][k], At[m][k], acc[ai][bj][m][n], 0, 0, 0); } __builtin_amdgcn_s_setprio(0); } while (0)
#define PG8_WAIT_V(n) asm volatile("s_waitcnt vmcnt(" #n ")" ::: "memory")
#define PG8_WAIT_L(n) asm volatile("s_waitcnt lgkmcnt(" #n ")" ::: "memory")
#define PG8_BAR __builtin_amdgcn_s_barrier()
#define PG8_SCHED __builtin_amdgcn_sched_barrier(0)
    Unit cur, nxt; int ui = 0;
    if (!S.next(0, cur)) return;
    Acc acc;
#pragma unroll
    for (int a = 0; a < 2; ++a)
#pragma unroll
        for (int b = 0; b < 2; ++b)
#pragma unroll
            for (int m = 0; m < 4; ++m)
#pragma unroll
                for (int n = 0; n < 2; ++n) acc[a][b][m][n] = (f32x4){0.f, 0.f, 0.f, 0.f};
    bf16x8 At[4][2], B0[2][2], B1[2][2];
    const char* cA = (const char*)g.A + (size_t)cur.pm * tstep; const char* cB = (const char*)g.Bt + (size_t)cur.pn * tstep;
    S.a_ready(cur);
    if constexpr (SP2) {
        PG8_STAGE(PG8_SB(0, 0), cB, voffB); PG8_STAGE(PG8_SB(0, 1), cB + hstep, voffB); PG8_STAGE(PG8_SA(0, 0), cA, voffA); PG8_STAGE(PG8_SA(0, 1), cA + hstep, voffA);
        if (wr == 1) PG8_BAR;
        PG8_WAIT_V(2); PG8_BAR;
        PG8_STAGE(PG8_SB(1, 0), cB + kstep, voffB); PG8_STAGE(PG8_SA(1, 0), cA + kstep, voffA); PG8_STAGE(PG8_SB(1, 1), cB + hstep + kstep, voffB);
        PG8_WAIT_V(6); PG8_BAR;
    } else {
        PG8_STAGE(PG8_SB(0, 0), cB, voffB); PG8_STAGE(PG8_SA(0, 0), cA, voffA); PG8_STAGE(PG8_SB(0, 1), cB + hstep, voffB); PG8_STAGE(PG8_SA(0, 1), cA + hstep, voffA);
        if (wr == 1) PG8_BAR;
        PG8_WAIT_V(4); PG8_BAR;
        PG8_STAGE(PG8_SB(1, 0), cB + kstep, voffB); PG8_STAGE(PG8_SA(1, 0), cA + kstep, voffA); PG8_STAGE(PG8_SB(1, 1), cB + hstep + kstep, voffB);
        PG8_WAIT_V(6); PG8_BAR;
    }
    for (;;) {
        const bool has_next = S.next(ui + 1, nxt);
        const char* nA = has_next ? (const char*)g.A + (size_t)nxt.pm * tstep : cA; const char* nB = has_next ? (const char*)g.Bt + (size_t)nxt.pn * tstep : cB;
        for (int t = 0; t < nt; t += 2) {
            const bool last = (t == nt - 2);
            const char* a1 = cA + (size_t)(t + 1) * kstep;
            const char* a2 = last ? nA : cA + (size_t)(t + 2) * kstep; const char* b2 = last ? nB : cB + (size_t)(t + 2) * kstep;
            const char* a3 = a2 + kstep; const char* b3 = b2 + kstep;
            if (last && has_next) S.a_ready(nxt);
            if constexpr (Mid::ENABLED) { if (t == (nt >> 1)) { if constexpr (MODE == 1) asm volatile("s_nop 15\n\ts_nop 15" ::: "memory"); MH(acc, ui, wr, fr); } }
            if constexpr (SP2) {
            const bool stg = epi_prefetch<Epi>::value && t == 0;
            PG8_LDB(B0, 0, 0); PG8_LDB(B1, 0, 1); PG8_SCHED; PG8_LDA(At, 0, 0); PG8_STAGE(PG8_SA(1, 1), a1 + hstep, voffA);
            if constexpr (epi_prefetch<Epi>::value) { if (stg) { E.stage(cur, wid, lane, sclb + (ui & 1) * 2048); PG8_WAIT_V(9); } else PG8_WAIT_V(8); } else PG8_WAIT_V(8);
            PG8_WAIT_L(0); PG8_BAR; PG8_MMA(0, 0, At, B0); PG8_MMA(0, 1, At, B1); PG8_BAR; PG8_SCHED;
            PG8_LDA(At, 0, 1); PG8_STAGE(PG8_SB(0, 0), b2, voffB); PG8_STAGE(PG8_SB(0, 1), b2 + hstep, voffB); PG8_STAGE(PG8_SA(0, 0), a2, voffA);
            if constexpr (epi_prefetch<Epi>::value) { if (stg) PG8_WAIT_V(9); else PG8_WAIT_V(8); } else PG8_WAIT_V(8);
            PG8_WAIT_L(0); PG8_BAR; PG8_MMA(1, 0, At, B0); PG8_MMA(1, 1, At, B1); PG8_BAR; PG8_SCHED;
            PG8_LDB(B0, 1, 0); PG8_LDB(B1, 1, 1); PG8_SCHED; PG8_LDA(At, 1, 0); PG8_STAGE(PG8_SA(0, 1), a2 + hstep, voffA);
            PG8_WAIT_V(8); PG8_WAIT_L(0); PG8_BAR; PG8_MMA(0, 0, At, B0); PG8_MMA(0, 1, At, B1); PG8_BAR; PG8_SCHED;
            PG8_LDA(At, 1, 1); PG8_STAGE(PG8_SB(1, 0), b3, voffB); PG8_STAGE(PG8_SB(1, 1), b3 + hstep, voffB); PG8_STAGE(PG8_SA(1, 0), a3, voffA);
            PG8_WAIT_V(8); PG8_WAIT_L(0); PG8_BAR; PG8_MMA(1, 0, At, B0); PG8_MMA(1, 1, At, B1); PG8_BAR; PG8_SCHED;
            } else {
            PG8_LDB(B0, 0, 0); PG8_SCHED; PG8_LDA(At, 0, 0); PG8_STAGE(PG8_SA(1, 1), a1 + hstep, voffA);
            PG8_WAIT_L(8); PG8_BAR; PG8_WAIT_L(0); PG8_MMA(0, 0, At, B0); PG8_BAR; PG8_SCHED;
            PG8_LDB(B1, 0, 1); PG8_STAGE(PG8_SB(0, 0), b2, voffB);
            PG8_BAR; PG8_WAIT_L(0); PG8_MMA(0, 1, At, B1); PG8_BAR;
            PG8_LDA(At, 0, 1); PG8_STAGE(PG8_SA(0, 0), a2, voffA);
            PG8_BAR; PG8_WAIT_L(0); PG8_MMA(1, 0, At, B0); PG8_BAR; PG8_SCHED;
            PG8_STAGE(PG8_SB(0, 1), b2 + hstep, voffB);
            PG8_WAIT_V(6); PG8_BAR; PG8_MMA(1, 1, At, B1); PG8_BAR;
            PG8_LDB(B0, 1, 0); PG8_SCHED; PG8_LDA(At, 1, 0); PG8_STAGE(PG8_SA(0, 1), a2 + hstep, voffA);
            PG8_WAIT_L(8); PG8_BAR; PG8_WAIT_L(0); PG8_MMA(0, 0, At, B0); PG8_BAR; PG8_SCHED;
            PG8_LDB(B1, 1, 1); PG8_STAGE(PG8_SB(1, 0), b3, voffB);
            PG8_BAR; PG8_WAIT_L(0); PG8_MMA(0, 1, At, B1); PG8_BAR;
            PG8_LDA(At, 1, 1); PG8_STAGE(PG8_SA(1, 0), a3, voffA);
            PG8_BAR; PG8_WAIT_L(0); PG8_MMA(1, 0, At, B0); PG8_BAR; PG8_SCHED;
            PG8_STAGE(PG8_SB(1, 1), b3 + hstep, voffB);
            PG8_WAIT_V(6); PG8_BAR; PG8_MMA(1, 1, At, B1); PG8_BAR;
            }
        }
        if constexpr (MODE == 1) asm volatile("s_nop 15\n\ts_nop 15" ::: "memory");
        if constexpr (ALIGN_EPI) { if (wr == 0) PG8_BAR; }
        if constexpr (epi_prefetch<Epi>::value) E(acc, cur, ui, wr, wc, fr, fq, sclb + (ui & 1) * 2048); else E(acc, cur, ui, wr, wc, fr, fq);
        if (!has_next) break;
#pragma unroll
        for (int a = 0; a < 2; ++a)
#pragma unroll
            for (int b = 0; b < 2; ++b)
#pragma unroll
                for (int m = 0; m < 4; ++m)
#pragma unroll
                    for (int n = 0; n < 2; ++n) acc[a][b][m][n] = (f32x4){0.f, 0.f, 0.f, 0.f};
        cur = nxt; cA = nA; cB = nB; ++ui;
        if constexpr (ALIGN_EPI) { if (wr == 1) PG8_BAR; }
    }
    PG8_WAIT_V(0);
    if constexpr (!ALIGN_EPI) { if (wr == 0) PG8_BAR; }
    PG8_BAR;
#undef PG8_SA
#undef PG8_SB
#undef PG8_STAGE
#undef PG8_LDA
#undef PG8_LDB
#undef PG8_MMA
#undef PG8_WAIT_V
#undef PG8_WAIT_L
#undef PG8_BAR
#undef PG8_SCHED
}
}

namespace moba {
constexpr int D = 128, SKV = 4096, OPITCH = 2048;
constexpr float SCALE = 0.08838834764831845f;
constexpr float THR = 8.f;
constexpr int NW = 8, QBLK = 32, KVBLK = 64, QB = NW * QBLK;
constexpr int SHM_V = KVBLK * D * 2, SHM_K = KVBLK * 272;
constexpr int NVS = 3;
constexpr int LDS_WS = NVS * SHM_V + 2 * SHM_K, LDS_KM = LDS_WS + NW * 64 * 4, LDS_BYTES = LDS_KM + 16 * 128 * 4;
typedef unsigned short bf16;
typedef short bf16x8 __attribute__((ext_vector_type(8)));
typedef short s16x4 __attribute__((ext_vector_type(4)));
typedef float f32x16 __attribute__((ext_vector_type(16)));
typedef float f32x4 __attribute__((ext_vector_type(4)));
typedef float f32x2 __attribute__((ext_vector_type(2)));
typedef unsigned u32x4 __attribute__((ext_vector_type(4)));

constexpr int KPITCH = 272;
#define KSWZ(row, colB) ((row) * KPITCH + (colB))
#define SBAR() __builtin_amdgcn_sched_barrier(0)
__device__ __forceinline__ int v_st(int k, int c) { const int kk = k;     return ((kk >> 3) * 4 + (c >> 5)) * 512 + ((kk & 7) * 32 + (c & 31)) * 2; }
__device__ __forceinline__ int v_rd_base(int lane) { return ((lane & 3) << 3) | (((lane >> 2) & 3) << 6) | (((lane >> 4) & 1) << 5) | (((lane >> 5) & 1) << 8); }
constexpr int v_rd_off(int d0, int ks, int half) { return d0 * 512 + ks * 4096 + half * 2048; }
__device__ __forceinline__ int crow(int r, int hi) { return (r & 3) + 8 * (r >> 2) + 4 * hi; }
__device__ __forceinline__ unsigned cvtpk(float lo, float hi) { unsigned r; asm volatile("v_cvt_pk_bf16_f32 %0, %1, %2" : "=v"(r) : "v"(lo), "v"(hi)); return r; }
__device__ __forceinline__ bf16x8 load8(const bf16* p) { return *reinterpret_cast<const bf16x8*>(p); }
__device__ __forceinline__ bf16x8 load8nt(const bf16* p) { return __builtin_nontemporal_load(reinterpret_cast<const bf16x8*>(p)); }
__device__ __forceinline__ void mask_tile(f32x16& p0, f32x16& p1, int dq) {
    const float NEG = -__builtin_inff();
#define MT1(P, r, cc) do { float t_ = P[r]; asm volatile("v_cmp_gt_i32_e32 vcc, %2, %1\n\tv_cndmask_b32_e32 %0, %0, %3, vcc" : "+v"(t_) : "v"(dq), "n"(cc), "v"(NEG) : "vcc"); P[r] = t_; } while (0)
#define MT2(r) do { MT1(p0, r, ((r) & 3) + 8 * ((r) >> 2)); MT1(p1, r, ((r) & 3) + 8 * ((r) >> 2) + 32); } while (0)
    MT2(0); MT2(1); MT2(2); MT2(3); MT2(4); MT2(5); MT2(6); MT2(7); MT2(8); MT2(9); MT2(10); MT2(11); MT2(12); MT2(13); MT2(14); MT2(15);
#undef MT2
#undef MT1
}
constexpr float THR2 = THR * 1.4426950408889634f;
__device__ __forceinline__ void partialSM(f32x16& p0, f32x16& p1, float& negm, float& l_reg, float& alpha) {
    float pmax = fmaxf(p0[0], p0[1]); for (int r = 2; r < 16; ++r) pmax = fmaxf(pmax, p0[r]); for (int r = 0; r < 16; ++r) pmax = fmaxf(pmax, p1[r]);
    { auto rr = __builtin_amdgcn_permlane32_swap(__float_as_uint(pmax), __float_as_uint(pmax), false, false);
      pmax = fmaxf(__uint_as_float(rr[0]), __uint_as_float(rr[1])); }
    const float NINF = -__builtin_inff();
    const bool sb = l_reg > 0.f;
    alpha = 1.f;
    if (__builtin_expect(!__all(pmax <= (sb ? THR2 : NINF)), 0)) {
        const float mc = pmax - negm;
        const float mold = sb ? -negm : NINF;
        const float mnew = fmaxf(mold, mc);
        const bool seen = mnew > NINF;
        const float delta = seen ? mnew + negm : 0.f;
        if (sb) alpha = __builtin_amdgcn_exp2f(mold - mnew);
        if (seen) negm = -mnew;
        l_reg *= alpha;
        for (int r = 0; r < 16; ++r) p0[r] -= delta; for (int r = 0; r < 16; ++r) p1[r] -= delta;
    }
    for (int r = 0; r < 16; ++r) p0[r] = __builtin_amdgcn_exp2f(p0[r]);
}
__device__ __forceinline__ void finishSM(f32x16& p0, f32x16& p1, float& l_reg, bf16x8& pa0, bf16x8& pa1, bf16x8& pa2, bf16x8& pa3) {
    for (int r = 0; r < 16; ++r) p1[r] = __builtin_amdgcn_exp2f(p1[r]);
    f32x2 s2 = {p0[0], p0[1]};
    for (int i = 1; i < 8; ++i) s2 += (f32x2){p0[2 * i], p0[2 * i + 1]};
    for (int i = 0; i < 8; ++i) s2 += (f32x2){p1[2 * i], p1[2 * i + 1]};
    float ps = s2[0] + s2[1];
    { auto rr = __builtin_amdgcn_permlane32_swap(__float_as_uint(ps), __float_as_uint(ps), false, false);
      ps = __uint_as_float(rr[0]) + __uint_as_float(rr[1]); }
    l_reg += ps;
#define PK4(P, B_, OUT) do { u32x4 w = {cvtpk(P[B_+0], P[B_+1]), cvtpk(P[B_+2], P[B_+3]), cvtpk(P[B_+4], P[B_+5]), cvtpk(P[B_+6], P[B_+7])}; OUT = *reinterpret_cast<bf16x8*>(&w); } while (0)
    PK4(p0, 0, pa0); PK4(p0, 8, pa1); PK4(p1, 0, pa2); PK4(p1, 8, pa3);
#undef PK4
}
template <int KB>
__device__ __forceinline__ void qkt(f32x16& p0, f32x16& p1, const char* K_lds, int r32, int hi, const bf16x8* qr, float init) {
    for (int r = 0; r < 16; ++r) { p0[r] = init; p1[r] = init; }
    const char* kb = K_lds + KB * SHM_K + KSWZ(r32, hi * 16);
#pragma unroll
    for (int d0 = 0; d0 < 8; ++d0) { const char* a = kb + d0 * 32;
        bf16x8 b0 = *reinterpret_cast<const bf16x8*>(a);
        bf16x8 b1 = *reinterpret_cast<const bf16x8*>(a + 32 * KPITCH);
        p0 = __builtin_amdgcn_mfma_f32_32x32x16_bf16(b0, qr[d0], p0, 0, 0, 0);
        p1 = __builtin_amdgcn_mfma_f32_32x32x16_bf16(b1, qr[d0], p1, 0, 0, 0); }
}
template <int VB>
__device__ __forceinline__ void pv_tile(f32x16* o, int vb0, bf16x8 pa0, bf16x8 pa1, bf16x8 pa2, bf16x8 pa3) {
#define TRRD(dst, off) asm volatile("ds_read_b64_tr_b16 %0, %1 offset:%2" : "=&v"(dst) : "v"(vb0), "i"(off) : "memory")
#define PV_D0(d0) do { s16x4 l0, l1, l2, l3, h0, h1, h2, h3; constexpr int b_ = VB * SHM_V + v_rd_off(d0, 0, 0);     \
        TRRD(l0, b_); TRRD(h0, b_ + 2048); TRRD(l1, b_ + 4096); TRRD(h1, b_ + 6144); TRRD(l2, b_ + 8192); TRRD(h2, b_ + 10240); TRRD(l3, b_ + 12288); TRRD(h3, b_ + 14336); \
        asm volatile("s_waitcnt lgkmcnt(0)" ::: "memory"); SBAR();                 \
        o[d0] = __builtin_amdgcn_mfma_f32_32x32x16_bf16(pa0, (bf16x8){l0[0], l0[1], l0[2], l0[3], h0[0], h0[1], h0[2], h0[3]}, o[d0], 0, 0, 0);   \
        o[d0] = __builtin_amdgcn_mfma_f32_32x32x16_bf16(pa1, (bf16x8){l1[0], l1[1], l1[2], l1[3], h1[0], h1[1], h1[2], h1[3]}, o[d0], 0, 0, 0);   \
        o[d0] = __builtin_amdgcn_mfma_f32_32x32x16_bf16(pa2, (bf16x8){l2[0], l2[1], l2[2], l2[3], h2[0], h2[1], h2[2], h2[3]}, o[d0], 0, 0, 0);   \
        o[d0] = __builtin_amdgcn_mfma_f32_32x32x16_bf16(pa3, (bf16x8){l3[0], l3[1], l3[2], l3[3], h3[0], h3[1], h3[2], h3[3]}, o[d0], 0, 0, 0); } while (0)
    PV_D0(0); PV_D0(1); PV_D0(2); PV_D0(3);
#undef PV_D0
#undef TRRD
}
struct BlockRef { const bf16* Q; const bf16* K; const bf16* V; unsigned char* O; float* SS; const float* KM; int P0; };
struct Seam { bf16x8 qr[8]; bf16x8 st_v0, st_v1, st_k0, st_k1; };
#define ROW(p, k0, rr) ((p) + (size_t)((k0) + (rr)) * D + sc)
#define VMW() asm volatile("s_waitcnt vmcnt(0)" ::: "memory")
#define VMWN(n) asm volatile("s_waitcnt vmcnt(%0)" :: "i"(n) : "memory")
#define SLOAD_H(Kp, Vp, k0) do { S.st_v0 = load8(ROW(Vp, k0, sr)); S.st_v1 = load8(ROW(Vp, k0, 32 + sr));              \
                         S.st_k0 = load8(ROW(Kp, k0, sr)); S.st_k1 = load8(ROW(Kp, k0, 32 + sr)); } while (0)
#define SWRITE_HK(bf) do { *(bf16x8*)(K_lds + (bf) * SHM_K + kws) = S.st_k0; *(bf16x8*)(K_lds + (bf) * SHM_K + kws + 32 * KPITCH) = S.st_k1; } while (0)
#define SWRITE_HV(bf) do { *(bf16x8*)(V_lds + (bf) * SHM_V + vst0) = S.st_v0; *(bf16x8*)(V_lds + (bf) * SHM_V + vst1) = S.st_v1; } while (0)
#define SWRITE_H(bf) do { SWRITE_HV(bf); SWRITE_HK(bf); } while (0)
__device__ __forceinline__ void moba_prime(const BlockRef& cur, char* lds, Seam& S) {
    int tid_o = threadIdx.x; asm volatile("" : "+v"(tid_o));
    const int tid = tid_o, wid = __builtin_amdgcn_readfirstlane(tid >> 6), lane = tid & 63, r32 = lane & 31, hi = lane >> 5;
    const int sr = tid >> 4, sc = (tid & 15) * 8, kws = KSWZ(sr, sc * 2); char* K_lds = lds + NVS * SHM_V;
    for (int d0 = 0; d0 < 8; ++d0) S.qr[d0] = load8nt(cur.Q + (size_t)(wid * QBLK + r32) * D + d0 * 16 + hi * 8);
    SLOAD_H(cur.K, cur.V, 0); VMW(); SWRITE_HK(0);
    __syncthreads();
}
__device__ __forceinline__ unsigned moba_select(const BlockRef& cur, char* lds, const Seam& S) {
    int tid_o = threadIdx.x; asm volatile("" : "+v"(tid_o));
    const int tid = tid_o, lane = tid & 63, hi = lane >> 5;
    const int own = cur.P0 >> 8;
    float* km = (float*)(lds + LDS_KM);
    __syncthreads();
    *(f32x4*)(km + tid * 4) = *(const f32x4*)(cur.KM + tid * 4);
    __syncthreads();
    float v1 = -__builtin_inff(), v2 = v1, v3 = v1; int i1 = 31, i2 = 31, i3 = 31;
    for (int j = 0; j < own; ++j) {
        const float* kr = km + j * 128 + hi * 8; float a = 0.f;
#pragma unroll
        for (int d0 = 0; d0 < 8; ++d0) { const f32x4 k0 = *(const f32x4*)(kr + d0 * 16), k1 = *(const f32x4*)(kr + d0 * 16 + 4); const bf16x8 q = S.qr[d0];
#pragma unroll
            for (int e = 0; e < 4; ++e) { a = fmaf(__uint_as_float((unsigned)(unsigned short)q[e] << 16), k0[e], a); a = fmaf(__uint_as_float((unsigned)(unsigned short)q[4 + e] << 16), k1[e], a); } }
        const float t = a + __shfl_xor(a, 32);
        if (t > v1) { v3 = v2; i3 = i2; v2 = v1; i2 = i1; v1 = t; i1 = j; }
        else if (t > v2) { v3 = v2; i3 = i2; v2 = t; i2 = j; }
        else if (t > v3) { v3 = t; i3 = j; }
    }
    return ((1u << i1) | (1u << i2) | (1u << i3)) & 0xffffu;
}
__device__ __forceinline__ void moba_block(const BlockRef& cur, const BlockRef& nxt, unsigned sel, char* lds, Seam& S) {
    int tid_o = threadIdx.x; asm volatile("" : "+v"(tid_o));
    const int tid = tid_o, wid = __builtin_amdgcn_readfirstlane(tid >> 6), lane = tid & 63, r32 = lane & 31, hi = lane >> 5;
    const int NT = cur.P0 / KVBLK + 4;
    const int qlo = cur.P0 + wid * QBLK, qm = qlo + r32 - 4 * hi;
    char* V_lds = lds; char* K_lds = lds + NVS * SHM_V;
    float* ws = (float*)(lds + LDS_WS) + wid * 64; float* li_l = ws, * al_l = ws + 32;
    float l_reg = 0, negm = 0.f; f32x16 o[4] = {};
    const int sr = tid >> 4, sc = (tid & 15) * 8, vst0 = v_st(sr, sc), vst1 = v_st(32 + sr, sc), kws = KSWZ(sr, sc * 2);
    const int vb0 = (int)(uintptr_t)V_lds + v_rd_base(lane);
    const bf16* Kh = cur.K; const bf16* Vh = cur.V;
#define RESC(a) do { if (__any((a) < 1.f)) { if (hi == 0) al_l[r32] = (a); asm volatile("s_waitcnt lgkmcnt(0)" ::: "memory");              \
                     for (int d_ = 0; d_ < 4; ++d_) for (int r = 0; r < 16; ++r) o[d_][r] *= al_l[crow(r, hi)]; } } while (0)
#define KBASE(t) ((t) * KVBLK)
#define TINIT(t) ((KBASE(t) < cur.P0 && ((sel >> (KBASE(t) >> 8)) & 1u) == 0u) ? -__builtin_inff() : negm)
#define MASKT(P0_, P1_, t) do { const int kb_ = KBASE(t); if (kb_ >= cur.P0 && kb_ + KVBLK - 1 > qlo) mask_tile(P0_, P1_, qm - kb_); } while (0)
    constexpr int NQL = 8;
#define SEAM_K0() do { VMWN(NQL); SWRITE_HK(0); SBAR(); } while (0)
    f32x16 pA0, pA1, pB0, pB1; bf16x8 pa0, pa1, pa2, pa3;
    SWRITE_HV(0); SBAR();
    SLOAD_H(Kh, Vh, KBASE(1));
    SBAR(); qkt<0>(pA0, pA1, K_lds, r32, hi, S.qr, TINIT(0));
    MASKT(pA0, pA1, 0); { float al0_; partialSM(pA0, pA1, negm, l_reg, al0_); }
    VMW(); SWRITE_H(1);
    __syncthreads();
#define HALF_STEP(PX0, PX1, PY0, PY1, t, KB, SB) do { float alX;                                                    \
        if ((t) + 1 < NT) { SBAR(); SLOAD_H(Kh, Vh, KBASE((t) + 1)); }     \
        SBAR(); qkt<KB>(PX0, PX1, K_lds, r32, hi, S.qr, TINIT(t));                                             \
        finishSM(PY0, PY1, l_reg, pa0, pa1, pa2, pa3); SBAR();                                                           \
        pv_tile<0>(o, vb0 + vs * SHM_V, pa0, pa1, pa2, pa3); MASKT(PX0, PX1, (t)); partialSM(PX0, PX1, negm, l_reg, alX);                                        \
        if ((t) + 1 < NT) { VMW(); SWRITE_HK(SB); SWRITE_HV(vs == 0 ? 2 : vs - 1); }     \
        RESC(alX); vs = vs == 2 ? 0 : vs + 1; __syncthreads(); } while (0)
    int vs = 0;
    for (int t = 1; t + 1 < NT; t += 2) {
        HALF_STEP(pB0, pB1, pA0, pA1, t, 1, 0);
        HALF_STEP(pA0, pA1, pB0, pB1, t + 1, 0, 1);
    }
    { SBAR(); qkt<1>(pB0, pB1, K_lds, r32, hi, S.qr, TINIT(NT - 1)); SBAR(); }
    SLOAD_H(nxt.K, nxt.V, 0); SBAR();
#pragma unroll
    for (int d0 = 0; d0 < 8; ++d0) S.qr[d0] = load8nt(nxt.Q + (size_t)(wid * QBLK + r32) * D + d0 * 16 + hi * 8);
    SBAR();
    finishSM(pA0, pA1, l_reg, pa0, pa1, pa2, pa3); SBAR();
    pv_tile<0>(o, vb0 + vs * SHM_V, pa0, pa1, pa2, pa3);
    { float alB; MASKT(pB0, pB1, NT - 1); partialSM(pB0, pB1, negm, l_reg, alB); __syncthreads(); RESC(alB);
      finishSM(pB0, pB1, l_reg, pa0, pa1, pa2, pa3); SBAR(); pv_tile<0>(o, vb0 + (vs == 2 ? 0 : vs + 1) * SHM_V, pa0, pa1, pa2, pa3); }
    SBAR(); SEAM_K0();
    if (hi == 0) li_l[r32] = l_reg; asm volatile("s_waitcnt lgkmcnt(0)" ::: "memory");
    float rli[16];
#pragma unroll
    for (int r = 0; r < 16; ++r) rli[r] = __builtin_amdgcn_rcpf(li_l[crow(r, hi)]);
    char* Ow = (char*)(cur.O + (size_t)(wid * QBLK) * OPITCH);
    unsigned obase = (unsigned)(hi * 4 * OPITCH + r32); asm volatile("" : "+v"(obase));
#pragma unroll
    for (int r = 0; r < 16; ++r) { const int orow = crow(r, hi); float ss = 0.f; const unsigned off = obase + (unsigned)(((r & 3) + 8 * (r >> 2)) * OPITCH);
#pragma unroll
        for (int d0 = 0; d0 < 4; ++d0) { const float v = o[d0][r] * rli[r]; ss = fmaf(v, v, ss);
            const float v16 = __builtin_amdgcn_fmed3f(v * 16.0f, -448.0f, 448.0f); const unsigned bq = (unsigned)__builtin_amdgcn_cvt_pk_fp8_f32(v16, v16, 0, false) & 0xffu;
            const unsigned x1 = __shfl_xor(bq, 1), x2 = __shfl_xor(bq, 2), x3 = __shfl_xor(x1, 2);
            if ((r32 & 3) == 0) *(unsigned*)(Ow + off + d0 * 32) = bq | (x1 << 8) | (x2 << 16) | (x3 << 24); }
        ss += __shfl_xor(ss, 1); ss += __shfl_xor(ss, 2); ss += __shfl_xor(ss, 4); ss += __shfl_xor(ss, 8); ss += __shfl_xor(ss, 16);
        if (r32 == 0) cur.SS[wid * QBLK + orow] = ss; }
    __syncthreads();
#undef RESC
#undef KBASE
#undef MASKT
#undef TINIT
#undef SEAM_K0
#undef HALF_STEP
}
#undef ROW
#undef VMW
#undef VMWN
#undef SLOAD_H
#undef SWRITE_HK
#undef SWRITE_HV
#undef SWRITE_H
#undef KSWZ
#undef SBAR
}

constexpr int NWAVES = 8;
#ifndef MK_N_LAUNCHES
#define MK_N_LAUNCHES 1
#endif
constexpr int N_PHASES = 11;
constexpr int N_LAUNCHES = MK_N_LAUNCHES;
static_assert(N_LAUNCHES == 1 || N_LAUNCHES == N_PHASES, "MK_N_LAUNCHES is 1 or 11");

constexpr int BATCH = 4, SEQ = 4096, DM = 2048, M = BATCH * SEQ;
constexpr int NH = 8, HD = 128, AW = 1024, RW = 1024, NRB = 16, RBD = 64;
constexpr int INC = 5120, DFF = 5504, NGU = 2 * DFF;
constexpr float EPS = 1e-6f;

constexpr size_t MiB = 1u << 20;
constexpr size_t WS_CTL = 0, CTL_ZERO_BYTES = 64 * 1024;
constexpr size_t WS_KMEAN = 512 * 1024;
constexpr size_t WS_ROPE = 1 * MiB;
constexpr size_t WS_SSA = 2 * MiB;
constexpr size_t WS_SSR = 3 * MiB;
constexpr int P0_GU2 = 264;
constexpr int DFFP = 5632;
constexpr size_t WS_SC = 7 * MiB;
constexpr size_t WS_WGU1 = 8 * MiB;
constexpr size_t WS_WD1 = 51 * MiB;
constexpr size_t WS_WIN = 73 * MiB;
constexpr size_t WS_WOUT = 93 * MiB;
constexpr size_t WS_WGU2 = 101 * MiB;
constexpr size_t WS_WD2 = 123 * MiB;
constexpr size_t WS_H = 134 * MiB;
constexpr size_t WS_ACT = 198 * MiB;
constexpr size_t WS_CG = 370 * MiB;
constexpr size_t WS_OL = 402 * MiB;
constexpr size_t WS_END = 434 * MiB;
static_assert(true, "");
constexpr size_t ACT_Q = 0, ACT_K = 32 * MiB, ACT_V = 64 * MiB, ACT_XR = 96 * MiB, ACT_GR = 128 * MiB;
static_assert(WS_WGU1 + (size_t)M * DM * 2 <= WS_WIN, "residual overlay");
static_assert(WS_WGU1 + (size_t)NGU * DM * 2 <= WS_WD1 && WS_WD1 + (size_t)DM * DFF * 2 <= WS_WIN && WS_WIN + (size_t)INC * DM * 2 <= WS_WOUT && WS_WOUT + (size_t)DM * DM * 2 <= WS_WGU2 &&
              WS_WGU2 + (size_t)NGU * DM <= WS_WD2 && WS_WD2 + (size_t)DM * DFFP <= WS_H && WS_H + (size_t)M * DM * 2 <= WS_ACT && WS_ACT + (size_t)M * DFF * 2 <= WS_END && 5 * 32 * MiB <= (size_t)M * DFF * 2 && (size_t)M * DFFP <= (size_t)M * DFF * 2, "d_ws map");
constexpr int CW_TMO = 0, CW_CODE = 1, CW_Q1 = 2048, CW_Q8 = 2112, CW_BAR = 4096;

constexpr int RING_OFF = 0, RING_BYTES = 131072;
constexpr int LDSCTL_OFF = RING_BYTES, MISC_OFF = LDSCTL_OFF + 320, SCL_OFF = LDSCTL_OFF + 1024;
constexpr int LDS_BYTES = 147456;
static_assert(SCL_OFF + 8192 <= LDS_BYTES && moba::LDS_BYTES <= RING_BYTES, "LDS map");

#define GAS __attribute__((address_space(1)))
#define LAS __attribute__((address_space(3)))
typedef unsigned short bf16;
typedef unsigned v4u __attribute__((ext_vector_type(4)));
typedef float f32x4 __attribute__((ext_vector_type(4)));
typedef short bf16x8 __attribute__((ext_vector_type(8)));
typedef GAS unsigned gu32;
typedef GAS unsigned long long gu64;
#define RLX_AGENT __ATOMIC_RELAXED, __HIP_MEMORY_SCOPE_AGENT
#define LDS_WAIT() asm volatile("s_waitcnt lgkmcnt(0)" ::: "memory")
#define VM_WAIT() asm volatile("s_waitcnt vmcnt(0)" ::: "memory")
__device__ __forceinline__ unsigned long long rt() { return __builtin_amdgcn_s_memrealtime(); }
__device__ __forceinline__ unsigned f2bf(float f) { unsigned u = __builtin_bit_cast(unsigned, f); return (u + 0x7fffu + ((u >> 16) & 1u)) >> 16; }
__device__ __forceinline__ unsigned pk2(float lo, float hi) { return f2bf(lo) | (f2bf(hi) << 16); }

#define XB_TMO      128
#define XB_XCNT(j)  (256  + 64 * (j))
#define XB_XSUB(j)  (1280 + 64 * (j))
#define XB_XGEN(j)  (2304 + 64 * (j))
#define XB_TOP      3328
#define XB_TOPGEN   3392
#define XCD_BAR_WORDS 3456
#define XB_SPIN_CAP (1u << 18)

__device__ __forceinline__ unsigned xb_ld(unsigned* p)              { return __hip_atomic_load(p, __ATOMIC_RELAXED, __HIP_MEMORY_SCOPE_AGENT); }
__device__ __forceinline__ unsigned xb_add(unsigned* p, unsigned v) { return __hip_atomic_fetch_add(p, v, __ATOMIC_RELAXED, __HIP_MEMORY_SCOPE_AGENT); }
__device__ __forceinline__ unsigned xb_xcc_id() { return (unsigned)__builtin_amdgcn_s_getreg((3 << 11) | 20) & 0xFu; }
#define XB_SPIN(cond, bar) do { unsigned _sp = 0; while (cond) { __builtin_amdgcn_s_sleep(1); \
    if ((++_sp & 255u) == 0u) { if (xb_ld(&(bar)[XB_TMO])) break; if (_sp > XB_SPIN_CAP) { atomicAdd(&(bar)[XB_TMO], 1u); break; } } } } while (0)

struct XcdBarrier {
    unsigned* bar; unsigned x;
    volatile LAS unsigned* st;
};

__device__ __forceinline__ XcdBarrier xcd_barrier_post(unsigned* bar, volatile LAS unsigned* st) {
    XcdBarrier b; b.bar = bar; b.x = xb_xcc_id(); b.st = st;
    if (threadIdx.x == 0) (void)xb_add(&bar[XB_XCNT(b.x)], 1u);
    return b;
}
__device__ __forceinline__ void xcd_barrier_complete(unsigned* bar, unsigned x, unsigned& nloc, unsigned& nx) {
    const unsigned G = gridDim.x * gridDim.y * gridDim.z;
    unsigned sum, cnt, mine, sp = 0u;
    for (;;) {
        sum = 0u; cnt = 0u; mine = 0u;
#pragma unroll
        for (unsigned j = 0; j < 16; ++j) { const unsigned c = xb_ld(&bar[XB_XCNT(j)]); sum += c; cnt += (c > 0u) ? 1u : 0u; mine = (j == x) ? c : mine; }
        if (sum == G) break;
        __builtin_amdgcn_s_sleep(1);
        if ((++sp & 255u) == 0u) { if (xb_ld(&bar[XB_TMO])) break; if (sp > XB_SPIN_CAP) { atomicAdd(&bar[XB_TMO], 1u); break; } }
    }
    nloc = mine > 0u ? mine : 1u; nx = cnt > 0u ? cnt : 1u;
}

__device__ __forceinline__ void xcd_barrier(const XcdBarrier& b) {
    asm volatile("s_waitcnt vmcnt(0)" ::: "memory");
    __syncthreads();
    if (threadIdx.x == 0) {
        unsigned* bar = b.bar;
        __builtin_amdgcn_s_waitcnt(0);
        unsigned nloc = b.st[0], nx = b.st[1];
        if (nloc == 0u) { xcd_barrier_complete(bar, b.x, nloc, nx); b.st[0] = nloc; b.st[1] = nx; }
        const unsigned old = xb_add(&bar[XB_XSUB(b.x)], 1u);
        const unsigned gen = old / nloc;
        if (old + 1u == (gen + 1u) * nloc) {
            __builtin_amdgcn_fence(__ATOMIC_RELEASE, "agent");
            asm volatile("s_waitcnt vmcnt(0)" ::: "memory");
            const unsigned og = xb_add(&bar[XB_TOP], 1u);
            const unsigned tg = og / nx;
            __builtin_amdgcn_fence(__ATOMIC_ACQUIRE, "agent");
            if (og + 1u == (tg + 1u) * nx) xb_add(&bar[XB_TOPGEN], 1u);
            else XB_SPIN(xb_ld(&bar[XB_TOPGEN]) == tg, bar);
            xb_add(&bar[XB_XGEN(b.x)], 1u);
            asm volatile("s_waitcnt vmcnt(0)" ::: "memory");
        } else {
            __builtin_amdgcn_fence(__ATOMIC_ACQUIRE, "agent");
            XB_SPIN(xb_ld(&bar[XB_XGEN(b.x)]) == gen, bar);
            asm volatile("s_waitcnt vmcnt(0)" ::: "memory");
        }
    }
    __syncthreads();
}

struct Frame {
    LAS unsigned char* lds;
    volatile LAS unsigned* MISC;
    gu32* ctl;
    int vcu, G;
};
__device__ __forceinline__ float wave_sum(float v) {
#pragma unroll
    for (int o = 1; o < 64; o <<= 1) v += __shfl_xor(v, o);
    return v;
}
__device__ __forceinline__ float wave_max(float v) {
#pragma unroll
    for (int o = 1; o < 64; o <<= 1) v = fmaxf(v, __shfl_xor(v, o));
    return v;
}
__device__ __forceinline__ unsigned pack_i8x4(f32x4 v) {
    const int a = (int)__builtin_rintf(v.x), b = (int)__builtin_rintf(v.y), c = (int)__builtin_rintf(v.z), d = (int)__builtin_rintf(v.w);
    return (unsigned)(a & 0xff) | ((unsigned)(b & 0xff) << 8) | ((unsigned)(c & 0xff) << 16) | ((unsigned)d << 24);
}
__device__ __forceinline__ float amax4(f32x4 v) { return fmaxf(fmaxf(fabsf(v.x), fabsf(v.y)), fmaxf(fabsf(v.z), fabsf(v.w))); }
__device__ __forceinline__ float bf2f(unsigned short b) { return __uint_as_float((unsigned)b << 16); }
__device__ __forceinline__ void transpose_item(const float* W, int N, int Kd, bf16* WT, int k0, int n0, int drow0, const float* ksc, LAS float* scr, int lane, bool nts) {
    { f32x4 v[8];
#pragma unroll
      for (int i = 0; i < 8; ++i) v[i] = __builtin_nontemporal_load((const f32x4*)(W + (size_t)(k0 + 8 * i + (lane >> 3)) * N + n0 + 4 * (lane & 7)));
#pragma unroll
      for (int i = 0; i < 8; ++i) { const int kk = 8 * i + (lane >> 3); f32x4 t = v[i]; if (ksc) t = t * ksc[k0 + kk]; LAS float* d = scr + kk * 33 + 4 * (lane & 7); d[0] = t.x; d[1] = t.y; d[2] = t.z; d[3] = t.w; } }
    LDS_WAIT(); asm volatile("" ::: "memory");
    const int c = lane & 7;
#pragma unroll
    for (int j = 0; j < 4; ++j) { const int n = (lane >> 3) + 8 * j; const LAS float* s = scr + (8 * c) * 33 + n;
        v4u o; o.x = pk2(s[0 * 33], s[1 * 33]); o.y = pk2(s[2 * 33], s[3 * 33]); o.z = pk2(s[4 * 33], s[5 * 33]); o.w = pk2(s[6 * 33], s[7 * 33]);
        v4u* dp = (v4u*)(WT + (size_t)(drow0 + n) * Kd + k0 + 8 * c); if (nts) __builtin_nontemporal_store(o, dp); else *dp = o; }
    LDS_WAIT(); asm volatile("" ::: "memory");
}
__device__ __forceinline__ void transpose_item_f8(const float* W, int N, int Kd, unsigned char* WT, int k0, int n0, int drow0, float sc, const float* ksc, LAS float* scr, int lane, bool nts) {
    { f32x4 v[8];
#pragma unroll
      for (int i = 0; i < 8; ++i) v[i] = __builtin_nontemporal_load((const f32x4*)(W + (size_t)(k0 + 8 * i + (lane >> 3)) * N + n0 + 4 * (lane & 7)));
#pragma unroll
      for (int i = 0; i < 8; ++i) { const int kk = 8 * i + (lane >> 3); f32x4 t = v[i] * sc; if (ksc) t = t * ksc[k0 + kk]; LAS float* d = scr + kk * 33 + 4 * (lane & 7); d[0] = t.x; d[1] = t.y; d[2] = t.z; d[3] = t.w; } }
    LDS_WAIT(); asm volatile("" ::: "memory");
    const int c = lane & 7;
#pragma unroll
    for (int j = 0; j < 4; ++j) { const int n = (lane >> 3) + 8 * j; const LAS float* s = scr + (8 * c) * 33 + n;
        typedef unsigned u32x2v __attribute__((ext_vector_type(2)));
        u32x2v o; o.x = pg8::cvt4_fp8(s[0 * 33], s[1 * 33], s[2 * 33], s[3 * 33]); o.y = pg8::cvt4_fp8(s[4 * 33], s[5 * 33], s[6 * 33], s[7 * 33]);
        u32x2v* dp = (u32x2v*)(WT + (size_t)(drow0 + n) * Kd + k0 + 8 * c); if (nts) __builtin_nontemporal_store(o, dp); else *dp = o; }
    LDS_WAIT(); asm volatile("" ::: "memory");
}
__device__ __forceinline__ void transpose_matrix_f8(Frame& F, const float* W, int K, int N, int NC, unsigned char* WT, int Kd, float sc, const float* ksc, bool gu, LAS float* scr, int gw0, int NGW, bool nts = false) {
    const int nblk = NC / 32, nitems = (K / 64) * nblk;
    for (int it = gw0; it < nitems; it += NGW) { const int kb = it / nblk, nb = it - kb * nblk, n0 = 32 * nb; int drow0 = n0;
        if (gu) { const int half = n0 >= DFF, nn = n0 - half * DFF; drow0 = 256 * (nn >> 7) + 128 * half + (nn & 127); }
        transpose_item_f8(W, N, Kd, WT, 64 * kb, n0, drow0, sc, ksc, scr, ((int)threadIdx.x & 63), nts); }
}
__device__ __forceinline__ void transpose_matrix(Frame& F, const float* W, int K, int N, int NC, bf16* WT, int Kd, const float* ksc, bool gu, LAS float* scr, int gw0, int NGW, bool nts = false) {
    const int nblk = NC / 32, nitems = (K / 64) * nblk;
    for (int it = gw0; it < nitems; it += NGW) { const int kb = it / nblk, nb = it - kb * nblk, n0 = 32 * nb; int drow0 = n0;
        if (gu) { const int half = n0 >= DFF, nn = n0 - half * DFF; drow0 = 256 * (nn >> 7) + 128 * half + (nn & 127); }
        transpose_item(W, N, Kd, WT, 64 * kb, n0, drow0, ksc, scr, ((int)threadIdx.x & 63), nts); }
}
__device__ __forceinline__ void quant_strips_i8(Frame& F, const float* W, int N, unsigned char* WT, float* sw, bool gu, int s_first, int s_end, int stride, bool nts = false) {
    const int lane = (int)threadIdx.x & 63, wave = __builtin_amdgcn_readfirstlane((int)threadIdx.x >> 6), c8 = lane & 7, r8 = lane >> 3;
    LAS float* scr = (LAS float*)(F.lds + RING_OFF + wave * 16384); LAS float* mx = (LAS float*)(F.lds + RING_OFF + 12288);
    for (int it = s_first; it < s_end; it += stride) {
        const int n0 = 32 * it; int drow0 = n0;
        if (gu) { const int half = n0 >= DFF, nn = n0 - half * DFF; drow0 = 256 * (nn >> 7) + 128 * half + (nn & 127); }
        f32x4 v[4][8]; f32x4 m4 = {0.f, 0.f, 0.f, 0.f};
#pragma unroll
        for (int sb = 0; sb < 4; ++sb)
#pragma unroll
            for (int i = 0; i < 8; ++i) v[sb][i] = __builtin_nontemporal_load((const f32x4*)(W + (size_t)(256 * wave + 64 * sb + 8 * i + r8) * N + n0 + 4 * c8));
#pragma unroll
        for (int sb = 0; sb < 4; ++sb)
#pragma unroll
            for (int i = 0; i < 8; ++i) m4 = __builtin_elementwise_max(m4, __builtin_elementwise_abs(v[sb][i]));
#pragma unroll
        for (int j = 0; j < 4; ++j) { float t = m4[j]; t = fmaxf(t, __shfl_xor(t, 8)); t = fmaxf(t, __shfl_xor(t, 16)); t = fmaxf(t, __shfl_xor(t, 32)); m4[j] = t; }
        if (r8 == 0) *(LAS f32x4*)(mx + wave * 4096 + 4 * c8) = m4;
        __syncthreads();
        f32x4 am = *(const LAS f32x4*)(mx + 4 * c8);
#pragma unroll
        for (int w2 = 1; w2 < 8; ++w2) am = __builtin_elementwise_max(am, *(const LAS f32x4*)(mx + w2 * 4096 + 4 * c8));
        f32x4 sc;
#pragma unroll
        for (int j = 0; j < 4; ++j) sc[j] = am[j] > 0.f ? 127.0f / am[j] : 0.f;
        if (wave == 0 && r8 == 0) *(f32x4*)(sw + drow0 + 4 * c8) = am * (1.0f / 127.0f);
#pragma unroll
        for (int sb = 0; sb < 4; ++sb) {
#pragma unroll
            for (int i = 0; i < 8; ++i) { const f32x4 t = v[sb][i] * sc; LAS float* d = scr + (8 * i + r8) * 33 + 4 * c8; d[0] = t.x; d[1] = t.y; d[2] = t.z; d[3] = t.w; }
            LDS_WAIT(); asm volatile("" ::: "memory");
#pragma unroll
            for (int j = 0; j < 4; ++j) { const int n = r8 + 8 * j; const LAS float* s = scr + (8 * c8) * 33 + n;
                typedef unsigned u32x2v __attribute__((ext_vector_type(2)));
                u32x2v o; o.x = pack_i8x4((f32x4){s[0 * 33], s[1 * 33], s[2 * 33], s[3 * 33]}); o.y = pack_i8x4((f32x4){s[4 * 33], s[5 * 33], s[6 * 33], s[7 * 33]});
                u32x2v* dp = (u32x2v*)(WT + (size_t)(drow0 + n) * DM + 256 * wave + 64 * sb + 8 * c8); if (nts) __builtin_nontemporal_store(o, dp); else *dp = o; }
            LDS_WAIT(); asm volatile("" ::: "memory");
        }
        __syncthreads();
    }
}
__device__ __forceinline__ void sincos_tab(double a, float& c, float& s) {
    const double k = rint(a * 0.15915494309189535); double r = fma(-k, 6.283185307179586, a); r = fma(-k, 2.4492935982947064e-16, r);
    const double r2 = r * r; double sv = 1.0, cv = 1.0;
#pragma unroll
    for (int n = 14; n >= 1; --n) { sv = 1.0 - r2 * sv * (1.0 / (double)((2 * n) * (2 * n + 1))); cv = 1.0 - r2 * cv * (1.0 / (double)((2 * n - 1) * (2 * n))); }
    s = (float)(r * sv); c = (float)cv;
}
__device__ __forceinline__ void store_row_i8(const f32x4 (&o)[8], unsigned char* hrow8, float* shrow) {
    float am = 0.f;
#pragma unroll
    for (int i = 0; i < 8; ++i) am = fmaxf(am, amax4(o[i]));
    am = wave_max(am);
    const float sc = am > 0.f ? 127.0f / am : 0.f;
#pragma unroll
    for (int i = 0; i < 8; ++i) *(unsigned*)(hrow8 + 256 * i + 4 * ((int)threadIdx.x & 63)) = pack_i8x4(o[i] * sc);
    if (((int)threadIdx.x & 63) == 0) *shrow = am * (1.0f / 127.0f);
}
__device__ __forceinline__ void rms_rows(Frame& F, const float* x, const float* g, unsigned char* hout8, float* sh) {
    const int gw = F.vcu * NWAVES + __builtin_amdgcn_readfirstlane((int)threadIdx.x >> 6), NGW = F.G * NWAVES;
    f32x4 gv[8];
#pragma unroll
    for (int i = 0; i < 8; ++i) gv[i] = *(const f32x4*)(g + 256 * i + 4 * ((int)threadIdx.x & 63));
    for (int m = gw; m < M; m += NGW) {
        const float* xr = x + (size_t)m * DM + 4 * ((int)threadIdx.x & 63); f32x4 v[8]; float s = 0.f;
#pragma unroll
        for (int i = 0; i < 8; ++i) { v[i] = __builtin_nontemporal_load((const f32x4*)(xr + 256 * i)); s += (v[i].x * v[i].x + v[i].y * v[i].y) + (v[i].z * v[i].z + v[i].w * v[i].w); }
        const float rs = 1.0f / sqrtf(wave_sum(s) * (1.0f / DM) + EPS);
#pragma unroll
        for (int i = 0; i < 8; ++i) v[i] = v[i] * rs * gv[i];
        store_row_i8(v, hout8 + (size_t)m * DM, sh + m);
    }
}
template <int HAS_H  , bool BASE_BF16, bool OUT_BF16>
__device__ __forceinline__ void norm_res_rows(Frame& F, const bf16* src, const void* basev, void* outv, void* hout, unsigned char* hout8, float* sh, const float* gpost, const float* gpre, float alpha) {
    const int gw = F.vcu * NWAVES + __builtin_amdgcn_readfirstlane((int)threadIdx.x >> 6), NGW = F.G * NWAVES;
    f32x4 gp[8], gq[8];
#pragma unroll
    for (int i = 0; i < 8; ++i) { gp[i] = *(const f32x4*)(gpost + 256 * i + 4 * ((int)threadIdx.x & 63)) * alpha; if (HAS_H) gq[i] = *(const f32x4*)(gpre + 256 * i + 4 * ((int)threadIdx.x & 63)); }
    for (int m = gw; m < M; m += NGW) {
        const bf16* sr = src + (size_t)m * DM + 4 * ((int)threadIdx.x & 63); const size_t eo = (size_t)m * DM + 4 * ((int)threadIdx.x & 63);
        f32x4 f[8], x[8]; float s = 0.f;
#pragma unroll
        for (int i = 0; i < 8; ++i) { const unsigned long long w = __builtin_nontemporal_load((const unsigned long long*)(sr + 256 * i));
            if (BASE_BF16) { const unsigned long long bw = __builtin_nontemporal_load((const unsigned long long*)((const bf16*)basev + eo + 256 * i));
                x[i] = (f32x4){__uint_as_float((unsigned)bw << 16), __uint_as_float((unsigned)bw & 0xffff0000u), __uint_as_float((unsigned)(bw >> 32) << 16), __uint_as_float((unsigned)(bw >> 32) & 0xffff0000u)}; }
            else x[i] = __builtin_nontemporal_load((const f32x4*)((const float*)basev + eo + 256 * i));
            f[i] = (f32x4){__uint_as_float((unsigned)w << 16), __uint_as_float((unsigned)w & 0xffff0000u), __uint_as_float((unsigned)(w >> 32) << 16), __uint_as_float((unsigned)(w >> 32) & 0xffff0000u)};
            s += (f[i].x * f[i].x + f[i].y * f[i].y) + (f[i].z * f[i].z + f[i].w * f[i].w); }
        const float rs = 1.0f / sqrtf(wave_sum(s) * (1.0f / DM) + EPS);
        float s1 = 0.f;
#pragma unroll
        for (int i = 0; i < 8; ++i) { x[i] = x[i] + f[i] * rs * gp[i];
            if (OUT_BF16) __builtin_nontemporal_store((unsigned long long)pk2(x[i].x, x[i].y) | ((unsigned long long)pk2(x[i].z, x[i].w) << 32), (unsigned long long*)((bf16*)outv + eo + 256 * i)); else __builtin_nontemporal_store(x[i], (f32x4*)((float*)outv + eo + 256 * i));
            s1 += (x[i].x * x[i].x + x[i].y * x[i].y) + (x[i].z * x[i].z + x[i].w * x[i].w); }
        if (HAS_H) {
            const float rs1 = 1.0f / sqrtf(wave_sum(s1) * (1.0f / DM) + EPS);
            if (HAS_H == 1 || HAS_H == 3) { bf16* ho = (bf16*)hout + (size_t)m * DM + 4 * ((int)threadIdx.x & 63);
#pragma unroll
                for (int i = 0; i < 8; ++i) { const f32x4 o = x[i] * rs1 * gq[i]; *(unsigned long long*)(ho + 256 * i) = (unsigned long long)pk2(o.x, o.y) | ((unsigned long long)pk2(o.z, o.w) << 32); } }
            if (HAS_H == 2 || HAS_H == 3) {
#pragma unroll
                for (int i = 0; i < 8; ++i) x[i] = x[i] * rs1 * gq[i];
                store_row_i8(x, (HAS_H == 2 ? (unsigned char*)hout : hout8) + (size_t)m * DM, sh + m); }
        }
    }
}

struct RecArgs { const bf16* XR; const bf16* GR; unsigned char* OUT  ; bf16* OL; bf16* CG  ; float* SSR  ;
                 const float *conv_w, *conv_b, *w_a, *b_a, *w_x, *b_x, *lam; };
__device__ __forceinline__ float sigmoidf_(float x) { return __builtin_amdgcn_rcpf(1.0f + __builtin_amdgcn_exp2f(-1.4426950408889634f * x)); }
constexpr int REC_XT = 35 * 144, REC_WAVE_LDS = 2 * REC_XT + 1024 + 2 * 1024 + 64;
static_assert(2048 + 8 * 14336 <= RING_BYTES && REC_WAVE_LDS <= 14336, "rec LDS");
__device__ __forceinline__ void rec_unit(Frame& F, const RecArgs& R, int b, int nb, int qq) {
    typedef float f32x4v __attribute__((ext_vector_type(4)));
    const int lane = (int)threadIdx.x & 63, wave = __builtin_amdgcn_readfirstlane((int)threadIdx.x >> 6), c = lane & 15, q = lane >> 4;
    const int ch = 64 * nb + 16 * qq + c;
    LAS float* sum = (LAS float*)(F.lds + RING_OFF);
    LAS unsigned char* wl = F.lds + RING_OFF + 2048 + wave * 14336;
    LAS unsigned char* gt = wl + 2 * REC_XT; LAS unsigned char* ot = gt + 1024; LAS unsigned char* ct = ot + 1024; LAS float* cinl = (LAS float*)(ct + 1024);
    bf16x8 ba[4][2], bx[4][2]; float bsa = 0.f, bsx = 0.f;
#pragma unroll
    for (int ks = 0; ks < 2; ++ks)
#pragma unroll
        for (int e = 0; e < 8; ++e) { const int k = 32 * ks + 8 * q + e; const size_t wi = ((size_t)nb * 64 + k) * 64 + 16 * qq + c; const float wa = R.w_a[wi], wx = R.w_x[wi];
            const float cbk = R.conv_b[64 * nb + k]; bsa = fmaf(cbk, wa, bsa); bsx = fmaf(cbk, wx, bsx);
#pragma unroll
            for (int tap = 0; tap < 4; ++tap) { const float cwk = R.conv_w[tap * RW + 64 * nb + k]; ba[tap][ks][e] = (short)f2bf(cwk * wa); bx[tap][ks][e] = (short)f2bf(cwk * wx); } }
    bsa += __shfl_xor(bsa, 16); bsa += __shfl_xor(bsa, 32); bsx += __shfl_xor(bsx, 16); bsx += __shfl_xor(bsx, 32);
    const float bac = R.b_a[ch] + bsa, bxc = R.b_x[ch] + bsx;
    const float lamv = R.lam[ch]; const float sp8 = -8.0f * log1pf(expf(-lamv)) * 1.4426950408889634f;
    const float cw0 = R.conv_w[ch], cw1 = R.conv_w[RW + ch], cw2 = R.conv_w[2 * RW + ch], cw3 = R.conv_w[3 * RW + ch], cbc = R.conv_b[ch];
    const size_t rowb = (size_t)b * SEQ;
    const int slot = nb * 4 + qq;
    const int trow = lane >> 1, thalf = lane & 1;
    v4u xq[5], gq;
#define REC_LOAD(tb_) do { _Pragma("unroll") for (int i_ = 0; i_ < 5; ++i_) { const int id_ = lane + 64 * i_, tt_ = (tb_) - 3 + (id_ >> 3); xq[i_] = (v4u){0u, 0u, 0u, 0u}; \
        if (id_ < 280 && tt_ >= 0) xq[i_] = *(const v4u*)(R.XR + (rowb + tt_) * RW + 64 * nb + 8 * (id_ & 7)); } \
        gq = __builtin_nontemporal_load((const v4u*)(R.GR + (rowb + (tb_) + trow) * RW + 64 * nb + 16 * qq + 8 * thalf)); } while (0)
    REC_LOAD(wave * 512);
    float st = 0.f, Pst = 1.f;
    for (int it = 0; it < 16; ++it) {
        const int tb = wave * 512 + it * 32;
        LAS unsigned char* xt = wl + (it & 1) * REC_XT;
#pragma unroll
        for (int i = 0; i < 5; ++i) { const int id = lane + 64 * i; if (id < 280) *(LAS v4u*)(xt + (id >> 3) * 144 + (id & 7) * 16) = xq[i]; }
        *(LAS v4u*)(gt + trow * 32 + thalf * 16) = gq;
        asm volatile("" ::: "memory");
        if (it + 1 < 16) REC_LOAD(tb + 32);
        f32x4v gr_[2], gi_[2];
#pragma unroll
        for (int mt = 0; mt < 2; ++mt) { gr_[mt] = (f32x4v){0.f, 0.f, 0.f, 0.f}; gi_[mt] = gr_[mt];
#pragma unroll
            for (int tap = 0; tap < 4; ++tap)
#pragma unroll
                for (int ks = 0; ks < 2; ++ks) { const bf16x8 af = *(const LAS bf16x8*)(xt + (16 * mt + c + tap) * 144 + (32 * ks + 8 * q) * 2);
                    gr_[mt] = __builtin_amdgcn_mfma_f32_16x16x32_bf16(af, ba[tap][ks], gr_[mt], 0, 0, 0); gi_[mt] = __builtin_amdgcn_mfma_f32_16x16x32_bf16(af, bx[tap][ks], gi_[mt], 0, 0, 0); } }
        float av[2][4], uv[2][4], gl[2][4], P[2], Hs[2];
#pragma unroll
        for (int mt = 0; mt < 2; ++mt) {
            float xs[7];
#pragma unroll
            for (int i = 0; i < 7; ++i) xs[i] = bf2f(*(const LAS unsigned short*)(xt + (16 * mt + 4 * q + i) * 144 + (16 * qq + c) * 2));
#pragma unroll
            for (int j = 0; j < 4; ++j) { const float xcv = fmaf(cw3, xs[j + 3], fmaf(cw2, xs[j + 2], fmaf(cw1, xs[j + 1], fmaf(cw0, xs[j], cbc))));
                const float r = sigmoidf_(gr_[mt][j] + bac), ig = sigmoidf_(gi_[mt][j] + bxc);
                const float a = __builtin_amdgcn_exp2f(r * sp8); av[mt][j] = a; uv[mt][j] = __builtin_amdgcn_sqrtf(fmaxf(1.0f - a * a, 0.f)) * (ig * xcv);
                const float g = bf2f(*(const LAS unsigned short*)(gt + (16 * mt + 4 * q + j) * 32 + c * 2)); gl[mt][j] = g * sigmoidf_(1.5957691216057308f * (g + 0.044715f * g * g * g)); }
            P[mt] = (av[mt][0] * av[mt][1]) * (av[mt][2] * av[mt][3]);
            Hs[mt] = fmaf(fmaf(fmaf(uv[mt][0], av[mt][1], uv[mt][1]), av[mt][2], uv[mt][2]), av[mt][3], uv[mt][3]); }
        float sin_[2], pin_[2]; { float s_ = st, p_ = Pst;
#pragma unroll
            for (int mt = 0; mt < 2; ++mt)
#pragma unroll
                for (int q2 = 0; q2 < 4; ++q2) { const float ps = __shfl(P[mt], c + 16 * q2), hs = __shfl(Hs[mt], c + 16 * q2);
                    if (q2 == q) { sin_[mt] = s_; pin_[mt] = p_; } s_ = fmaf(ps, s_, hs); p_ *= ps; }
            st = s_; Pst = p_; }
#pragma unroll
        for (int mt = 0; mt < 2; ++mt) { float h = sin_[mt], p = pin_[mt];
#pragma unroll
            for (int j = 0; j < 4; ++j) { h = fmaf(av[mt][j], h, uv[mt][j]); p *= av[mt][j];
                const unsigned oc = pg8::cvt_pk_bf16(h * gl[mt][j], p * gl[mt][j]);
                *(LAS unsigned short*)(ot + (16 * mt + 4 * q + j) * 32 + c * 2) = (unsigned short)oc;
                *(LAS unsigned short*)(ct + (16 * mt + 4 * q + j) * 32 + c * 2) = (unsigned short)(oc >> 16); } }
        asm volatile("" ::: "memory");
        { const v4u ov = *(const LAS v4u*)(ot + trow * 32 + thalf * 16), cv = *(const LAS v4u*)(ct + trow * 32 + thalf * 16);
          *(v4u*)(R.OL + ((size_t)slot * M + rowb + tb + trow) * 16 + 8 * thalf) = ov;
          *(v4u*)(R.CG + ((size_t)slot * M + rowb + tb + trow) * 16 + 8 * thalf) = cv; }
        asm volatile("" ::: "memory");
    }
#undef REC_LOAD
    if (q == 0) { sum[(wave * 16 + c) * 2] = Pst; sum[(wave * 16 + c) * 2 + 1] = st; }
    VM_WAIT(); __syncthreads();
    float cin = 0.f;
    for (int w2 = 0; w2 < wave; ++w2) cin = fmaf(sum[(w2 * 16 + c) * 2], cin, sum[(w2 * 16 + c) * 2 + 1]);
    if (q == 0) cinl[c] = cin;
    asm volatile("" ::: "memory");
    const f32x4v ci0 = *(const LAS f32x4v*)(cinl + 8 * thalf), ci1 = *(const LAS f32x4v*)(cinl + 8 * thalf + 4);
    const float cc[8] = {ci0[0], ci0[1], ci0[2], ci0[3], ci1[0], ci1[1], ci1[2], ci1[3]};
    for (int it0 = 0; it0 < 16; it0 += 8) {
    v4u ovs[8], cvs[8];
#pragma unroll
    for (int i8 = 0; i8 < 8; ++i8) { const size_t row = rowb + wave * 512 + (it0 + i8) * 32 + trow;
        ovs[i8] = *(const v4u*)(R.OL + ((size_t)slot * M + row) * 16 + 8 * thalf); cvs[i8] = *(const v4u*)(R.CG + ((size_t)slot * M + row) * 16 + 8 * thalf); }
#pragma unroll
    for (int i8 = 0; i8 < 8; ++i8) { const int it = it0 + i8; const size_t row = rowb + wave * 512 + it * 32 + trow;
        const v4u ov = ovs[i8], cv = cvs[i8];
        const unsigned ow[4] = {ov.x, ov.y, ov.z, ov.w}, cw_[4] = {cv.x, cv.y, cv.z, cv.w}; float o[8]; float s2 = 0.f;
#pragma unroll
        for (int e = 0; e < 4; ++e) { o[2 * e] = fmaf(cc[2 * e], __uint_as_float(cw_[e] << 16), __uint_as_float(ow[e] << 16)); o[2 * e + 1] = fmaf(cc[2 * e + 1], __uint_as_float(cw_[e] & 0xffff0000u), __uint_as_float(ow[e] & 0xffff0000u));
            s2 = fmaf(o[2 * e], o[2 * e], fmaf(o[2 * e + 1], o[2 * e + 1], s2)); }
        typedef unsigned u32x2v __attribute__((ext_vector_type(2)));
#pragma unroll
        for (int e = 0; e < 8; ++e) o[e] = __builtin_amdgcn_fmed3f(4.f * o[e], -448.0f, 448.0f);
        u32x2v w8; w8.x = pg8::cvt4_fp8(o[0], o[1], o[2], o[3]); w8.y = pg8::cvt4_fp8(o[4], o[5], o[6], o[7]);
        *(u32x2v*)(R.OUT + row * DM + AW + 64 * nb + 16 * qq + 8 * thalf) = w8;
        s2 += __shfl_xor(s2, 1);
        if (thalf == 0) R.SSR[(size_t)slot * M + row] = s2; } }
    __syncthreads();
}
struct Args { const float* in[22]; float* out; unsigned char* ws; double invf[16]; int ph_lo, ph_hi, li, pad; };
__global__ void __launch_bounds__(NWAVES * 64, 2) hyb_fwd(Args args) {
    extern __shared__ __attribute__((aligned(16))) unsigned char lds[];
    Frame F;
    F.lds = (LAS unsigned char*)lds;
    F.MISC = (volatile LAS unsigned*)(F.lds + MISC_OFF);
    F.G = gridDim.x; { const int bx = blockIdx.x; F.vcu = (F.G % 8 == 0) ? (bx % 8) * (F.G / 8) + bx / 8 : bx; }
    unsigned char* ws = args.ws;
    F.ctl = (gu32*)(ws + WS_CTL);
#define GRID_BAR(seam) do { if (N_LAUNCHES != 1) { if (((int)threadIdx.x) == 0) __hip_atomic_store(F.ctl + CW_TMO, 0xBADBA0u | (unsigned)(seam), RLX_AGENT); } else { xcd_barrier(bar); } } while (0)
    const float* x = args.in[0];
    unsigned char* Wgu1 = ws + WS_WGU1; unsigned char* Wd1 = ws + WS_WD1; float* swgu1 = (float*)(ws + WS_SC); float* swgu2 = (float*)(ws + WS_SC + 65536); float* swkvxg = (float*)(ws + WS_SC + 131072); float* shrow = (float*)(ws + WS_SC + 196608); unsigned char* Wkvxg = ws + WS_WIN;   unsigned char* Wout8 = ws + WS_WOUT; unsigned char* H8B = ws + WS_CG;
    unsigned char* Wgu2 = ws + WS_WGU2; unsigned char* Wd2 = ws + WS_WD2;
    bf16* H = (bf16*)(ws + WS_H); unsigned char* H8 = ws + WS_H; bf16* ACT = (bf16*)(ws + WS_ACT); unsigned char* ACT8 = ws + WS_ACT;
    bf16* Qh = (bf16*)(ws + WS_ACT + ACT_Q); bf16* Kh = (bf16*)(ws + WS_ACT + ACT_K); bf16* Vh = (bf16*)(ws + WS_ACT + ACT_V);
    bf16* XR = (bf16*)(ws + WS_ACT + ACT_XR); bf16* GR = (bf16*)(ws + WS_ACT + ACT_GR); bf16* Y = (bf16*)(ws + WS_ACT);
    float* rope = (float*)(ws + WS_ROPE); float* kmean = (float*)(ws + WS_KMEAN); float* ssa = (float*)(ws + WS_SSA); float* ssr = (float*)(ws + WS_SSR);
    float* out = args.out; bf16* XRES = (bf16*)(ws + WS_WGU1);
    for (int u = ((int)threadIdx.x); u < (LDS_BYTES - LDSCTL_OFF) / 4; u += NWAVES * 64) ((LAS unsigned*)(F.lds + LDSCTL_OFF))[u] = 0u;
    __syncthreads();
    XcdBarrier bar; bar.bar = (unsigned*)(F.ctl + CW_BAR); bar.x = 0; bar.st = nullptr;
    if (N_LAUNCHES == 1) bar = xcd_barrier_post((unsigned*)(F.ctl + CW_BAR), F.MISC + 8);
    const int lo = args.ph_lo, hi = args.ph_hi;
#ifndef PH_MASK
#define PH_MASK 0x7ff
#endif
#define IN(k) ((((PH_MASK) >> (k)) & 1) && lo <= (k) && (k) < hi)
#define BOTH(k) (IN(k) && IN((k) + 1))

    if (IN(0)) {
        LAS float* scr = (LAS float*)(F.lds + RING_OFF + __builtin_amdgcn_readfirstlane((int)threadIdx.x >> 6) * 16384);
        const int gw = F.vcu * NWAVES + __builtin_amdgcn_readfirstlane((int)threadIdx.x >> 6), NGW = F.G * NWAVES;
        for (int i = blockIdx.x * (NWAVES * 64) + ((int)threadIdx.x); i < SEQ * 16; i += F.G * NWAVES * 64) { float c, s; sincos_tab((double)(i >> 4) * args.invf[i & 15], c, s); rope[2 * i] = c; rope[2 * i + 1] = s; }
        for (int i = blockIdx.x * (NWAVES * 64) + (int)threadIdx.x; i < BATCH * NH * 16 * 128 / 4; i += F.G * NWAVES * 64) ((f32x4*)kmean)[i] = (f32x4){0.f, 0.f, 0.f, 0.f};
        {
          const int c = (int)blockIdx.x, G = F.G, o1 = NGU / 32, o2 = o1 + INC / 32;
          quant_strips_i8(F, args.in[2], NGU, Wgu1, swgu1, true, c % G, NGU / 32, G);
          quant_strips_i8(F, args.in[6], INC, Wkvxg, swkvxg, false, ((c - o1) % G + G) % G, INC / 32, G, true);
          quant_strips_i8(F, args.in[19], NGU, Wgu2, swgu2, true, ((c - o2) % G + G) % G, P0_GU2, G, true); }
        rms_rows(F, x, args.in[1], H8, shrow);
        transpose_matrix_f8(F, args.in[16], AW, DM, DM, Wout8, DM, 32.0f, args.in[14], false, scr, gw, NGW, true);
        transpose_matrix_f8(F, args.in[16] + (size_t)AW * DM, RW, DM, DM, Wout8 + AW, DM, 32.0f, args.in[15], false, scr, gw, NGW, true);
        if (BOTH(0)) GRID_BAR(0);
    }
    if (IN(1)) {
        pg8::Gemm g{(const bf16*)H8, (const bf16*)Wgu1, M, NGU, DM / 2}; pg8::StaticOrder S; S.init(M, NGU, F.G, (int)blockIdx.x);
        pg8::EpiSwiGLUI8 E{ACT8, DFFP, shrow, swgu1, NGU / 256 - 1};
        pg8::gemm_phase<pg8::EpiSwiGLUI8, pg8::StaticOrder, pg8::NoMid, true, true, 2>(F.lds + RING_OFF, g, S, E, pg8::NoMid{}, F.lds + LDSCTL_OFF + 10240);
        {
          constexpr int NS = NGU / 32 - P0_GU2, NTI = (DFF / 64) * (DM / 32), NCH = NTI / 8, NQ = NS + NCH + 1;
          static_assert(NTI % 8 == 0, "transpose chunks");
          volatile LAS unsigned* qs = F.MISC + 16;
          const int wv = __builtin_amdgcn_readfirstlane((int)threadIdx.x >> 6); LAS float* scr = (LAS float*)(F.lds + RING_OFF + wv * 16384);
          if ((int)threadIdx.x == 0) qs[0] = __hip_atomic_fetch_add(F.ctl + CW_Q1, 1u, RLX_AGENT);
          __syncthreads();
          for (;;) {
              const unsigned idx = qs[0];
              __syncthreads();
              if (idx >= (unsigned)NQ) break;
              unsigned nx = 0u; if ((int)threadIdx.x == 0) nx = __hip_atomic_fetch_add(F.ctl + CW_Q1, 1u, RLX_AGENT);
              if (idx < (unsigned)NS) quant_strips_i8(F, args.in[19], NGU, Wgu2, swgu2, true, P0_GU2 + (int)idx, P0_GU2 + (int)idx + 1, 1, true);
              else if (idx < (unsigned)(NS + NCH)) { const int it = ((int)idx - NS) * 8 + wv, nblk = DM / 32, kb = it / nblk, n0 = 32 * (it - kb * nblk);
                  transpose_item_f8(args.in[3], DM, DFFP, Wd1, 64 * kb, n0, n0, 64.0f, nullptr, scr, ((int)threadIdx.x & 63), false); }
              else { for (int i = (int)threadIdx.x; i < DM * 8; i += NWAVES * 64) *(v4u*)(Wd1 + (size_t)(i >> 3) * DFFP + DFF + 16 * (i & 7)) = (v4u){0u, 0u, 0u, 0u}; }
              if ((int)threadIdx.x == 0) qs[0] = nx;
              __syncthreads();
          } }
        if (BOTH(1)) GRID_BAR(1);
    }
    if (IN(2)) {
        pg8::Gemm g{(const bf16*)ACT8, (const bf16*)Wd1, M, DM, DFFP / 2}; pg8::StaticOrder S; S.init(M, DM, F.G, (int)blockIdx.x);
        pg8::EpiBf16 E{H, DM, 1.0f / 256.0f};
        pg8::gemm_phase<pg8::EpiBf16, pg8::StaticOrder, pg8::NoMid, true, true, true>(F.lds + RING_OFF, g, S, E, pg8::NoMid{});
        if (BOTH(2)) GRID_BAR(2);
    }
    if (IN(3)) {
        norm_res_rows<2, false, true>(F, H, x, XRES, H8B, nullptr, shrow, args.in[4], args.in[5], 0.5f);
        if (BOTH(3)) GRID_BAR(3);
    }
    if (IN(4)) {
        { pg8::Gemm g{(const bf16*)H8B, (const bf16*)Wkvxg, M, INC, DM / 2}; pg8::StaticOrder S; S.init(M, INC, F.G, (int)blockIdx.x);
          pg8::EpiKVXG E{ws + WS_ACT, shrow, swkvxg, rope, kmean};
          pg8::gemm_phase<pg8::EpiKVXG, pg8::StaticOrder, pg8::NoMid, true, true, 2>(F.lds + RING_OFF, g, S, E, pg8::NoMid{}); }
        if (BOTH(4)) GRID_BAR(4);
    }
    if (IN(5)) {
        char* al = (char*)lds + RING_OFF;
#ifndef NO_ATT
        for (int L = blockIdx.x; L < BATCH * NH * 8; L += F.G) {
            const int bh = (L & 7) * 4 + (L >> 6), y = (L >> 3) & 7, b = bh >> 3, h = bh & 7;
            const bf16* qb = Qh + (size_t)bh * SEQ * HD; const bf16* kb = Kh + (size_t)bh * SEQ * HD; const bf16* vb = Vh + (size_t)bh * SEQ * HD;
            moba::BlockRef r0, r1;
            r0.Q = qb + (size_t)(y * 256) * HD; r0.K = kb; r0.V = vb; r0.O = H8 + ((size_t)b * SEQ + y * 256) * DM + h * HD; r0.SS = ssa + (size_t)h * M + (size_t)b * SEQ + y * 256; r0.KM = kmean + (size_t)bh * 16 * 128; r0.P0 = y * 256;
            const int y1 = 15 - y;
            r1.Q = qb + (size_t)(y1 * 256) * HD; r1.K = kb; r1.V = vb; r1.O = H8 + ((size_t)b * SEQ + y1 * 256) * DM + h * HD; r1.SS = ssa + (size_t)h * M + (size_t)b * SEQ + y1 * 256; r1.KM = r0.KM; r1.P0 = y1 * 256;
            moba::Seam S;
            moba::moba_prime(r0, al, S);
            unsigned sel = moba::moba_select(r0, al, S);
            moba::moba_block(r0, r1, sel, al, S);
            sel = moba::moba_select(r1, al, S);
            moba::moba_block(r1, r1, sel, al, S);
            VM_WAIT(); __syncthreads();
        }
#endif
#ifndef NO_REC
        RecArgs R{XR, GR, H8, (bf16*)(ws + WS_OL), (bf16*)(ws + WS_CG), ssr, args.in[7], args.in[8], args.in[9], args.in[10], args.in[11], args.in[12], args.in[13]};
        for (int L = blockIdx.x; L < BATCH * NRB * 4; L += F.G) { const int bn = (L & 7) | ((L >> 5) << 3);
            rec_unit(F, R, bn >> 4, bn & 15, (L >> 3) & 3); }
#endif
        if (BOTH(5)) GRID_BAR(5);
    }
    if (IN(6)) {
        pg8::Gemm g{(const bf16*)H8, (const bf16*)Wout8, M, DM, DM / 2}; pg8::StaticOrder S; S.init(M, DM, F.G, (int)blockIdx.x);
        LAS float* scl = (LAS float*)(F.lds + SCL_OFF);
        { pg8::Unit u;
          for (int i0 = 0; i0 < 4; i0 += 2) { const int i = i0 + (((int)threadIdx.x) >> 8), r = ((int)threadIdx.x) & 255;
              if (S.next(i, u)) { const size_t row = (size_t)u.pm * 256 + r; float sa = 0.f, sr = 0.f;
#pragma unroll
              for (int hh = 0; hh < 8; ++hh) sa += ssa[(size_t)hh * M + row];
#pragma unroll
              for (int s = 0; s < 64; ++s) sr += ssr[(size_t)s * M + row];
              const float ra = 1.0f / sqrtf(sa * (1.0f / AW) + EPS), rr = 1.0f / sqrtf(sr * (1.0f / RW) + EPS);
              scl[(i * 256 + r) * 2] = 0.25f * ra / rr; scl[(i * 256 + r) * 2 + 1] = rr * (1.0f / 128.0f); } }
          __syncthreads(); }
        pg8::EpiRowScaleBf16 E{Y, DM, (const PG8_LAS float*)scl}; pg8::MidRowScale MH{(const PG8_LAS float*)scl};
        pg8::gemm_phase<pg8::EpiRowScaleBf16, pg8::StaticOrder, pg8::MidRowScale, true, true, true>(F.lds + RING_OFF, g, S, E, MH);
        if (BOTH(6)) GRID_BAR(6);
    }
    if (IN(7)) {
        norm_res_rows<2, true, true>(F, Y, XRES, XRES, H8, nullptr, shrow, args.in[17], args.in[18], 1.0f);
        if (BOTH(7)) GRID_BAR(7);
    }
    if (IN(8)) {
        pg8::Gemm g{(const bf16*)H8, (const bf16*)Wgu2, M, NGU, DM / 2}; pg8::StaticOrder S; S.init(M, NGU, F.G, (int)blockIdx.x);
        pg8::EpiSwiGLUI8 E{ACT8, DFFP, shrow, swgu2, NGU / 256 - 1};
        pg8::gemm_phase<pg8::EpiSwiGLUI8, pg8::StaticOrder, pg8::NoMid, true, true, 2>(F.lds + RING_OFF, g, S, E, pg8::NoMid{}, F.lds + LDSCTL_OFF + 10240);
        {
          constexpr int NTI = (DFF / 64) * (DM / 32), NCH = NTI / 8, NQ = NCH + 1;
          volatile LAS unsigned* qs = F.MISC + 16;
          const int wv = __builtin_amdgcn_readfirstlane((int)threadIdx.x >> 6); LAS float* scr = (LAS float*)(F.lds + RING_OFF + wv * 16384);
          if ((int)threadIdx.x == 0) qs[0] = __hip_atomic_fetch_add(F.ctl + CW_Q8, 1u, RLX_AGENT);
          __syncthreads();
          for (;;) {
              const unsigned idx = qs[0];
              __syncthreads();
              if (idx >= (unsigned)NQ) break;
              unsigned nx = 0u; if ((int)threadIdx.x == 0) nx = __hip_atomic_fetch_add(F.ctl + CW_Q8, 1u, RLX_AGENT);
              if (idx < (unsigned)NCH) { const int it = (int)idx * 8 + wv, nblk = DM / 32, kb = it / nblk, n0 = 32 * (it - kb * nblk);
                  transpose_item_f8(args.in[20], DM, DFFP, Wd2, 64 * kb, n0, n0, 64.0f, nullptr, scr, ((int)threadIdx.x & 63), false); }
              else { for (int i = (int)threadIdx.x; i < DM * 8; i += NWAVES * 64) *(v4u*)(Wd2 + (size_t)(i >> 3) * DFFP + DFF + 16 * (i & 7)) = (v4u){0u, 0u, 0u, 0u}; }
              if ((int)threadIdx.x == 0) qs[0] = nx;
              __syncthreads();
          } }
        if (BOTH(8)) GRID_BAR(8);
    }
    if (IN(9)) {
        pg8::Gemm g{(const bf16*)ACT8, (const bf16*)Wd2, M, DM, DFFP / 2}; pg8::StaticOrder S; S.init(M, DM, F.G, (int)blockIdx.x);
        pg8::EpiBf16 E{H, DM, 1.0f / 256.0f};
        pg8::gemm_phase<pg8::EpiBf16, pg8::StaticOrder, pg8::NoMid, true, true, true>(F.lds + RING_OFF, g, S, E, pg8::NoMid{});
        if (BOTH(9)) GRID_BAR(9);
    }
    if (IN(10)) {
        norm_res_rows<0, true, false>(F, H, XRES, out, nullptr, nullptr, nullptr, args.in[21], nullptr, 0.5f);
    }
#undef IN
#undef BOTH
}

extern "C" void kernel_launch(void* const* d_in, const int* in_sizes, int n_in, void* d_out, int out_size, void* d_ws, size_t ws_size, hipStream_t stream) {
    static int grid = 0;
    if (grid == 0) {
        if (n_in != 22 || in_sizes[0] != M * DM || out_size != M * DM || ws_size < WS_END) { fprintf(stderr, "kernel_launch: unexpected shapes (n_in %d, in0 %d, out %d, ws %zu)\n", n_in, n_in > 0 ? in_sizes[0] : -1, out_size, ws_size); grid = -1; return; }
        int dev = 0, cus = 0, per_cu = 0;
        if (hipGetDevice(&dev) != hipSuccess || hipDeviceGetAttribute(&cus, hipDeviceAttributeMultiprocessorCount, dev) != hipSuccess) { grid = -1; return; }
        if (hipFuncSetAttribute((const void*)hyb_fwd, hipFuncAttributeMaxDynamicSharedMemorySize, LDS_BYTES) != hipSuccess) { fprintf(stderr, "kernel_launch: hipFuncSetAttribute failed\n"); grid = -1; return; }
        if (hipOccupancyMaxActiveBlocksPerMultiprocessor(&per_cu, (const void*)hyb_fwd, NWAVES * 64, LDS_BYTES) != hipSuccess || per_cu < 1)
            fprintf(stderr, "kernel_launch: note: occupancy query reports %d workgroups per CU\n", per_cu);
        (void)hipGetLastError();
        grid = cus;
    }
    if (grid < 0) return;
    if (hipMemsetAsync((char*)d_ws + WS_CTL, 0, CTL_ZERO_BYTES, stream) != hipSuccess) return;
    Args a{};
    for (int i = 0; i < 22; ++i) a.in[i] = (const float*)d_in[i];
    a.out = (float*)d_out; a.ws = (unsigned char*)d_ws;
    for (int f = 0; f < 16; ++f) a.invf[f] = pow(500000.0, -(double)f / 16.0);
    for (int li = 0; li < N_LAUNCHES; ++li) {
        a.ph_lo = (N_LAUNCHES == 1) ? 0 : li; a.ph_hi = (N_LAUNCHES == 1) ? N_PHASES : li + 1; a.li = li; a.pad = 0;
        hipLaunchKernelGGL(hyb_fwd, dim3(grid), dim3(NWAVES * 64), LDS_BYTES, stream, a);
        const hipError_t le = hipPeekAtLastError();
        if (le != hipSuccess) { fprintf(stderr, "kernel_launch: launch %d failed: %s\n", li, hipGetErrorName(le)); break; }
#ifdef DUP_PHASE
        if (N_LAUNCHES == N_PHASES && li == DUP_PHASE) hipLaunchKernelGGL(hyb_fwd, dim3(grid), dim3(NWAVES * 64), LDS_BYTES, stream, a);
#endif
    }
}
```
